# Optimizing an MI355X kernel written in HIP

```python
import math
import jax
import jax.numpy as jnp
from jax import lax
import numpy as np


D_MODEL = 1024
BATCH = 4
SEQ = 8192
DEPTH = 1

NORM_EPS = 1e-6
NEG_INF = -1e30
Q_BLOCK = 128

DA_HEADS = 8
DA_DIM = 64
DA_VDIM = 2 * DA_DIM
DA_SUBLN_EPS = 1e-5

NSA_HEADS = 8
NSA_GROUPS = 2
NSA_HPG = NSA_HEADS // NSA_GROUPS
NSA_DIM = 64
CMP_BLOCK = 32
CMP_STRIDE = 16
CMP_HIDDEN = 128
SEL_BLOCK = 64
SEL_TOPK = 16
WINDOW = 512
FORCE_BONUS = 1e4

N_BRANCH = 2
N_ALIBI_HEADS = DA_HEADS + NSA_HEADS

N_EXPERTS = 64
MOE_TOPK = 8
N_EXPERT_GROUPS = 8
TOPK_EXPERT_GROUPS = 4
EXPERT_HIDDEN = 256
SHARED_HIDDEN = 256
ROUTED_SCALE = 2.5
MOE_BLOCK = 128

IN_SIZES = (
    DA_HEADS * 2 * DA_DIM,
    DA_HEADS * 2 * DA_DIM,
    DA_HEADS * DA_VDIM,
    NSA_HEADS * NSA_DIM,
    NSA_GROUPS * NSA_DIM,
    NSA_GROUPS * NSA_DIM,
    NSA_GROUPS * NSA_DIM,
    NSA_GROUPS * NSA_DIM,
    NSA_GROUPS * NSA_DIM,
    NSA_GROUPS * NSA_DIM,
    NSA_HEADS * 3,
    N_BRANCH * D_MODEL,
)
IN_COLS = 6424

kernel_name = 'hybrid_diffattn_nsa_moe_block'


def _lambda_init(layer):
    return 0.8 - 0.6 * math.exp(-0.3 * layer)


def _alibi_slopes():
    i = jnp.arange(1, N_ALIBI_HEADS + 1, dtype=jnp.float32)
    return 2.0 ** (-8.0 * i / N_ALIBI_HEADS)


def _rms(x, eps):
    xf = x.astype(jnp.float32)
    return xf * lax.rsqrt(jnp.mean(xf * xf, axis=-1, keepdims=True) + eps)


def _modulate(x, w, shift, scale):
    y = _rms(x, NORM_EPS) * w.astype(jnp.float32)
    return (y * (1.0 + scale[:, None, :]) + shift[:, None, :]).astype(x.dtype)


def _swiglu(x, w_gate, w_up, w_down):
    return (jax.nn.silu(x @ w_gate) * (x @ w_up)) @ w_down


def diff_attention(q, k, v, lam, slopes):
    B, H, _, S, _ = q.shape
    key_pos = jnp.arange(S)
    m = slopes[None, :, None, None, None]

    def one_block(i):
        q0 = i * Q_BLOCK
        qb = lax.dynamic_slice_in_dim(q, q0, Q_BLOCK, axis=3)
        dist = (q0 + jnp.arange(Q_BLOCK))[:, None] - key_pos[None, :]
        s = jnp.einsum('bhcqd,bhckd->bhcqk', qb, k) - m * dist.astype(jnp.float32)
        p = jax.nn.softmax(jnp.where(dist >= 0, s, NEG_INF), axis=-1)
        a = p[:, :, 0] - lam * p[:, :, 1]
        return jnp.einsum('bhqk,bhkd->bhqd', a, v)

    o = lax.map(one_block, jnp.arange(S // Q_BLOCK))
    return o.transpose(1, 2, 0, 3, 4).reshape(B, H, S, -1)


def compress_blocks(k, pe, w1, w2):
    B, G, S, Dh = k.shape
    n_cmp = (S - CMP_BLOCK) // CMP_STRIDE + 1
    idx = jnp.arange(n_cmp)[:, None] * CMP_STRIDE + jnp.arange(CMP_BLOCK)[None, :]
    blk = k[:, :, idx, :] + pe.astype(jnp.float32)
    flat = blk.reshape(B, G, n_cmp, CMP_BLOCK * Dh)
    return jax.nn.gelu(flat @ w1.astype(jnp.float32)) @ w2.astype(jnp.float32)


def _cmp_to_sel(n_cmp, n_sel):
    c0 = jnp.arange(n_cmp)[:, None] * CMP_STRIDE
    s0 = jnp.arange(n_sel)[None, :] * SEL_BLOCK
    ov = jnp.minimum(c0 + CMP_BLOCK, s0 + SEL_BLOCK) - jnp.maximum(c0, s0)
    return jnp.clip(ov, 0).astype(jnp.float32) / CMP_BLOCK


def nsa_attention(q, kc, vc, ks, vs, kw, vw, gates, slopes):
    B, G, Hg, S, Dh = q.shape
    n_cmp = kc.shape[2]
    n_sel = S // SEL_BLOCK
    n_top = min(SEL_TOPK, n_sel)
    cmp_pos = jnp.arange(n_cmp) * CMP_STRIDE + CMP_BLOCK - 1
    cmp_to_sel = _cmp_to_sel(n_cmp, n_sel)
    ks_blk = ks.reshape(B, G, n_sel, SEL_BLOCK, Dh)
    vs_blk = vs.reshape(B, G, n_sel, SEL_BLOCK, Dh)
    pad = ((0, 0), (0, 0), (WINDOW, 0), (0, 0))
    kw_pad = jnp.pad(kw, pad)
    vw_pad = jnp.pad(vw, pad)
    b_ix = jnp.arange(B)[:, None, None, None]
    g_ix = jnp.arange(G)[None, :, None, None]
    blk_ids = jnp.arange(n_sel)
    m = slopes[None, :, :, None, None]

    def one_block(i):
        q0 = i * Q_BLOCK
        t = q0 + jnp.arange(Q_BLOCK)
        qb = lax.dynamic_slice_in_dim(q, q0, Q_BLOCK, axis=3)
        gb = lax.dynamic_slice_in_dim(gates, q0, Q_BLOCK, axis=3)
        d_c = t[:, None] - cmp_pos[None, :]
        ok_c = d_c >= 0
        s_c = jnp.einsum('bghqd,bgcd->bghqc', qb, kc) - m * d_c.astype(jnp.float32)
        p_c = jax.nn.softmax(jnp.where(ok_c, s_c, NEG_INF), axis=-1) * ok_c
        o_c = jnp.einsum('bghqc,bgcd->bghqd', p_c, vc)
        imp = jnp.einsum('bghqc,cn->bgqn', p_c, cmp_to_sel)
        cur = t // SEL_BLOCK
        forced = (blk_ids[None, :] == 0) | (blk_ids[None, :] == cur[:, None]) | (blk_ids[None, :] == cur[:, None] - 1)
        causal_blk = blk_ids[None, :] * SEL_BLOCK <= t[:, None]
        sel_score = jnp.where(causal_blk, imp + FORCE_BONUS * forced, NEG_INF)
        _, sel = lax.top_k(sel_score, n_top)
        k_sel = ks_blk[b_ix, g_ix, sel]
        v_sel = vs_blk[b_ix, g_ix, sel]
        tok = sel[..., None] * SEL_BLOCK + jnp.arange(SEL_BLOCK)
        d_s = (t[:, None, None] - tok)[:, :, None]
        s_s = jnp.einsum('bghqd,bgqnld->bghqnl', qb, k_sel) - m[..., None] * d_s.astype(jnp.float32)
        s_s = jnp.where(d_s >= 0, s_s, NEG_INF).reshape(B, G, Hg, Q_BLOCK, n_top * SEL_BLOCK)
        p_s = jax.nn.softmax(s_s, axis=-1).reshape(B, G, Hg, Q_BLOCK, n_top, SEL_BLOCK)
        o_s = jnp.einsum('bghqnl,bgqnld->bghqd', p_s, v_sel)
        k_w = lax.dynamic_slice_in_dim(kw_pad, q0, Q_BLOCK + WINDOW, axis=2)
        v_w = lax.dynamic_slice_in_dim(vw_pad, q0, Q_BLOCK + WINDOW, axis=2)
        key_pos = q0 - WINDOW + jnp.arange(Q_BLOCK + WINDOW)
        d_w = t[:, None] - key_pos[None, :]
        ok_w = (d_w >= 0) & (d_w < WINDOW) & (key_pos[None, :] >= 0)
        s_w = jnp.einsum('bghqd,bgkd->bghqk', qb, k_w) - m * d_w.astype(jnp.float32)
        p_w = jax.nn.softmax(jnp.where(ok_w, s_w, NEG_INF), axis=-1)
        o_w = jnp.einsum('bghqk,bgkd->bghqd', p_w, v_w)
        return gb[..., 0:1] * o_c + gb[..., 1:2] * o_s + gb[..., 2:3] * o_w

    o = lax.map(one_block, jnp.arange(S // Q_BLOCK))
    return o.transpose(1, 0, 4, 2, 3, 5).reshape(B, S, G * Hg * Dh)


def hybrid_mixer(h, w_in, lq1, lk1, lq2, lk2, subln_w, ck_pe, ck_w1, ck_w2, cv_pe, cv_w1, cv_w2,
                 w_da_out, w_nsa_out, w_o, lam_init):
    B, S, D = h.shape
    f32 = jnp.float32
    proj = h @ w_in
    offsets = np.cumsum(IN_SIZES)[:-1].tolist()
    (da_q, da_k, da_v, nsa_q, c_k, c_v, s_k, s_v, w_k, w_v, nsa_g, merge_g) = jnp.split(proj, offsets, axis=-1)
    slopes = _alibi_slopes()
    slopes_a = slopes[0::2]
    slopes_b = slopes[1::2]

    qa = da_q.reshape(B, S, DA_HEADS, 2, DA_DIM).transpose(0, 2, 3, 1, 4).astype(f32) * (DA_DIM ** -0.5)
    ka = da_k.reshape(B, S, DA_HEADS, 2, DA_DIM).transpose(0, 2, 3, 1, 4).astype(f32)
    va = da_v.reshape(B, S, DA_HEADS, DA_VDIM).transpose(0, 2, 1, 3).astype(f32)
    lam = (jnp.exp(jnp.sum(lq1.astype(f32) * lk1.astype(f32)))
           - jnp.exp(jnp.sum(lq2.astype(f32) * lk2.astype(f32))) + lam_init)
    oa = diff_attention(qa, ka, va, lam, slopes_a)
    oa = _rms(oa, DA_SUBLN_EPS) * subln_w.astype(f32) * (1.0 - lam_init)
    oa = oa.transpose(0, 2, 1, 3).reshape(B, S, DA_HEADS * DA_VDIM).astype(h.dtype)

    def kv_groups(t):
        return t.reshape(B, S, NSA_GROUPS, NSA_DIM).transpose(0, 2, 1, 3).astype(f32)
    qb = nsa_q.reshape(B, S, NSA_GROUPS, NSA_HPG, NSA_DIM).transpose(0, 2, 3, 1, 4).astype(f32) * (NSA_DIM ** -0.5)
    kc = compress_blocks(kv_groups(c_k), ck_pe, ck_w1, ck_w2)
    vc = compress_blocks(kv_groups(c_v), cv_pe, cv_w1, cv_w2)
    gates = jax.nn.sigmoid(nsa_g.astype(f32)).reshape(B, S, NSA_GROUPS, NSA_HPG, 3).transpose(0, 2, 3, 1, 4)
    ob = nsa_attention(qb, kc, vc, kv_groups(s_k), kv_groups(s_v), kv_groups(w_k), kv_groups(w_v),
                       gates, slopes_b.reshape(NSA_GROUPS, NSA_HPG)).astype(h.dtype)

    ya = oa @ w_da_out
    yb = ob @ w_nsa_out
    g = jax.nn.sigmoid(merge_g.astype(f32)).reshape(B, S, N_BRANCH, D)
    merged = (g[:, :, 0] * ya + g[:, :, 1] * yb).astype(h.dtype)
    return merged @ w_o


def _routed_experts(xf, top_e, top_w, w_gate, w_up, w_down):
    N, D = xf.shape
    K = top_e.shape[1]
    E = w_gate.shape[0]
    flat_e = top_e.reshape(-1)
    order = jnp.argsort(flat_e)
    sorted_e = flat_e[order]
    counts = jnp.bincount(flat_e, length=E)
    padded = ((counts + MOE_BLOCK - 1) // MOE_BLOCK) * MOE_BLOCK
    start = jnp.cumsum(counts) - counts
    pend = jnp.cumsum(padded)
    pstart = pend - padded
    dest = pstart[sorted_e] + jnp.arange(N * K) - start[sorted_e]
    n_rows = ((N * K + E * (MOE_BLOCK - 1) + MOE_BLOCK - 1) // MOE_BLOCK) * MOE_BLOCK
    n_blk = n_rows // MOE_BLOCK
    row_tok = jnp.full((n_rows,), N, jnp.int32).at[dest].set((order // K).astype(jnp.int32))
    row_w = jnp.zeros((n_rows,), jnp.float32).at[dest].set(top_w.reshape(-1)[order])
    blk_e = jnp.clip(jnp.searchsorted(pend, jnp.arange(n_blk) * MOE_BLOCK, side='right'), 0, E - 1)
    x_pad = jnp.concatenate([xf, jnp.zeros((1, D), xf.dtype)], axis=0)

    def one_group(args):
        tok, e = args
        xb = x_pad[tok]
        return _swiglu(xb, w_gate[e], w_up[e], w_down[e])

    y = lax.map(one_group, (row_tok.reshape(n_blk, MOE_BLOCK), blk_e))
    y = y.reshape(n_rows, D).astype(jnp.float32) * row_w[:, None]
    return jax.ops.segment_sum(y, row_tok, num_segments=N + 1)[:N]


def moe_ffn(h, router_w, router_b, w_gate, w_up, w_down, sw_gate, sw_up, sw_down):
    B, S, D = h.shape
    N = B * S
    xf = h.reshape(N, D)
    scores = jax.nn.sigmoid((xf @ router_w).astype(jnp.float32))
    biased = scores + router_b.astype(jnp.float32)
    grp = biased.reshape(N, N_EXPERT_GROUPS, N_EXPERTS // N_EXPERT_GROUPS)
    grp_score = jnp.sum(lax.top_k(grp, 2)[0], axis=-1)
    _, top_g = lax.top_k(grp_score, TOPK_EXPERT_GROUPS)
    g_mask = jnp.sum(jax.nn.one_hot(top_g, N_EXPERT_GROUPS, dtype=jnp.float32), axis=1) > 0
    e_mask = jnp.repeat(g_mask, N_EXPERTS // N_EXPERT_GROUPS, axis=1)
    _, top_e = lax.top_k(jnp.where(e_mask, biased, NEG_INF), MOE_TOPK)
    top_w = jnp.take_along_axis(scores, top_e, axis=1)
    top_w = top_w / jnp.sum(top_w, axis=-1, keepdims=True) * ROUTED_SCALE
    routed = _routed_experts(xf, top_e, top_w, w_gate, w_up, w_down)
    shared = _swiglu(xf, sw_gate, sw_up, sw_down).astype(jnp.float32)
    return (routed + shared).astype(h.dtype).reshape(B, S, D)


def setup_inputs(seed: int = 0) -> dict:
    key = jax.random.key(seed)
    ks = jax.random.split(key, 30)
    f32 = jnp.float32

    def nrm(k, shape, scale):
        return jax.random.normal(k, shape, f32) * scale

    D = D_MODEL
    L = DEPTH
    return {
        'x': nrm(ks[0], (BATCH, SEQ, D), 1.0),
        'c': nrm(ks[1], (BATCH, D), 1.0),
        'ada_w': nrm(ks[2], (L, D, 6 * D), 0.5 * D ** -0.5),
        'ada_b': nrm(ks[3], (L, 6 * D), 0.02),
        'norm1_w': 1.0 + nrm(ks[4], (L, D), 0.02),
        'w_in': nrm(ks[5], (L, D, IN_COLS), D ** -0.5),
        'da_lq1': nrm(ks[6], (L, DA_DIM), 0.1),
        'da_lk1': nrm(ks[7], (L, DA_DIM), 0.1),
        'da_lq2': nrm(ks[8], (L, DA_DIM), 0.1),
        'da_lk2': nrm(ks[9], (L, DA_DIM), 0.1),
        'da_subln_w': 1.0 + nrm(ks[10], (L, DA_VDIM), 0.02),
        'cmp_k_pe': nrm(ks[11], (L, CMP_BLOCK, NSA_DIM), 0.02),
        'cmp_k_w1': nrm(ks[12], (L, CMP_BLOCK * NSA_DIM, CMP_HIDDEN), (CMP_BLOCK * NSA_DIM) ** -0.5),
        'cmp_k_w2': nrm(ks[13], (L, CMP_HIDDEN, NSA_DIM), CMP_HIDDEN ** -0.5),
        'cmp_v_pe': nrm(ks[14], (L, CMP_BLOCK, NSA_DIM), 0.02),
        'cmp_v_w1': nrm(ks[15], (L, CMP_BLOCK * NSA_DIM, CMP_HIDDEN), (CMP_BLOCK * NSA_DIM) ** -0.5),
        'cmp_v_w2': nrm(ks[16], (L, CMP_HIDDEN, NSA_DIM), CMP_HIDDEN ** -0.5),
        'w_da_out': nrm(ks[17], (L, DA_HEADS * DA_VDIM, D), (DA_HEADS * DA_VDIM) ** -0.5),
        'w_nsa_out': nrm(ks[18], (L, NSA_HEADS * NSA_DIM, D), (NSA_HEADS * NSA_DIM) ** -0.5),
        'w_o': nrm(ks[19], (L, D, D), D ** -0.5),
        'norm2_w': 1.0 + nrm(ks[20], (L, D), 0.02),
        'router_w': nrm(ks[21], (L, D, N_EXPERTS), D ** -0.5),
        'router_b': nrm(ks[22], (L, N_EXPERTS), 0.01),
        'exp_w_gate': nrm(ks[23], (L, N_EXPERTS, D, EXPERT_HIDDEN), D ** -0.5),
        'exp_w_up': nrm(ks[24], (L, N_EXPERTS, D, EXPERT_HIDDEN), D ** -0.5),
        'exp_w_down': nrm(ks[25], (L, N_EXPERTS, EXPERT_HIDDEN, D), EXPERT_HIDDEN ** -0.5),
        'sh_w_gate': nrm(ks[26], (L, D, SHARED_HIDDEN), D ** -0.5),
        'sh_w_up': nrm(ks[27], (L, D, SHARED_HIDDEN), D ** -0.5),
        'sh_w_down': nrm(ks[28], (L, SHARED_HIDDEN, D), SHARED_HIDDEN ** -0.5),
        'final_norm_w': 1.0 + nrm(ks[29], (D,), 0.02),
    }


def reference(x, c, ada_w, ada_b, norm1_w, w_in, da_lq1, da_lk1, da_lq2, da_lk2, da_subln_w,
              cmp_k_pe, cmp_k_w1, cmp_k_w2, cmp_v_pe, cmp_v_w1, cmp_v_w2, w_da_out, w_nsa_out, w_o,
              norm2_w, router_w, router_b, exp_w_gate, exp_w_up, exp_w_down,
              sh_w_gate, sh_w_up, sh_w_down, final_norm_w):
    f32 = jnp.float32
    c_act = jax.nn.silu(c.astype(f32))
    for l in range(DEPTH):
        mod = c_act @ ada_w[l].astype(f32) + ada_b[l].astype(f32)
        sh1, sc1, g1, sh2, sc2, g2 = jnp.split(mod, 6, axis=-1)
        h = _modulate(x, norm1_w[l], sh1, sc1)
        mix = hybrid_mixer(h, w_in[l], da_lq1[l], da_lk1[l], da_lq2[l], da_lk2[l], da_subln_w[l],
                           cmp_k_pe[l], cmp_k_w1[l], cmp_k_w2[l], cmp_v_pe[l], cmp_v_w1[l], cmp_v_w2[l],
                           w_da_out[l], w_nsa_out[l], w_o[l], _lambda_init(l))
        x = (x + g1[:, None, :] * mix).astype(x.dtype)
        h = _modulate(x, norm2_w[l], sh2, sc2)
        ffn = moe_ffn(h, router_w[l], router_b[l], exp_w_gate[l], exp_w_up[l], exp_w_down[l],
                      sh_w_gate[l], sh_w_up[l], sh_w_down[l])
        x = (x + g2[:, None, :] * ffn).astype(x.dtype)
    return (_rms(x, NORM_EPS) * final_norm_w.astype(f32)).astype(x.dtype)
```

```cpp
#include <hip/hip_runtime.h>
#include <hip/hip_cooperative_groups.h>
#include <cstdio>
#include <cstdint>
namespace cg = cooperative_groups;

#define LAS __attribute__((address_space(3)))
#define GAS __attribute__((address_space(1)))
typedef unsigned short bf16_t;
typedef short bf16x8 __attribute__((ext_vector_type(8)));
typedef short s16x4 __attribute__((ext_vector_type(4)));
typedef float f32x2 __attribute__((ext_vector_type(2)));
typedef float f32x4 __attribute__((ext_vector_type(4)));
typedef float f32x16 __attribute__((ext_vector_type(16)));
typedef unsigned u32x2 __attribute__((ext_vector_type(2)));
typedef unsigned u32x4 __attribute__((ext_vector_type(4)));

constexpr int NTHREADS = 512, NWAVES = 8;
constexpr int LDS_BYTES = 147456;
constexpr int BATCH = 4, SEQ = 8192, DM = 1024, NTOK = BATCH * SEQ;
constexpr int PROJ_W = 4352;
constexpr int NIN = 6656;
constexpr int C_DAQ = 0, C_DAK = 1024, C_DAV = 2048, C_NQ = 3072, C_CK = 3584, C_CV = 3712, C_SK = 3840, C_SV = 3968, C_WK = 4096, C_WV = 4224;
constexpr int NEXP = 64, EH = 256, CAP = NTOK;
constexpr int NSPLIT = 2, YW = DM / NSPLIT;
constexpr float LOG2E = 1.4426950408889634f;
constexpr float QSCALE = 0.125f * LOG2E;
constexpr float NEG_INF = -__builtin_huge_valf();

constexpr size_t MiB = 1u << 20, KiB = 1024;
constexpr size_t WS_CTL = 0;
constexpr int CW_KCMAX = 96;
constexpr size_t WS_BAR = 16 * KiB;
constexpr size_t WS_MOD = 64 * KiB;
constexpr size_t WS_KSN = 240 * KiB;
constexpr size_t WS_RBIAS = 160 * KiB;
constexpr size_t WS_KTN = 192 * KiB;
constexpr size_t WS_RSLOT = 1 * MiB;
constexpr size_t WS_RW = 9 * MiB;
constexpr size_t WS_WDN = 17 * MiB;
constexpr size_t WS_SHDN = 49 * MiB;
constexpr size_t WS_WGU = 50 * MiB;
constexpr size_t WS_SHGU = 114 * MiB;
constexpr size_t WS_WIN = 115 * MiB;
constexpr size_t WS_WDA = 128 * MiB;
constexpr size_t WS_WNSA = 130 * MiB;
constexpr size_t WS_WO = 131 * MiB;
constexpr size_t WS_CKW1 = 133 * MiB;
constexpr size_t WS_CVW1 = 133 * MiB + 512 * KiB;
constexpr size_t WS_CKW2 = 134 * MiB;
constexpr size_t WS_CVW2 = 134 * MiB + 64 * KiB;
constexpr size_t WS_RHI = 134 * MiB + 128 * KiB;
constexpr size_t WS_RLO = 134 * MiB + 256 * KiB;
constexpr size_t WS_KC = 135 * MiB;
constexpr size_t WS_VC = 135 * MiB + 512 * KiB;
constexpr size_t WS_NSAG = 136 * MiB;
constexpr size_t WS_XN = 140 * MiB;
constexpr size_t WS_PROJ = 204 * MiB;
constexpr size_t WS_OB = 476 * MiB;
constexpr size_t WS_MERGED = 204 * MiB;
constexpr size_t WS_LO = 268 * MiB;
constexpr size_t WS_ACT = 367 * MiB;
constexpr size_t WS_YS = 50 * MiB;
constexpr size_t WS_END = 512 * MiB;

struct Params { const float* in[30]; float* out; unsigned char* ws; };

__device__ __forceinline__ unsigned f2bf(float f) { unsigned u = __builtin_bit_cast(unsigned, f); return (u + 0x7fffu + ((u >> 16) & 1u)) >> 16; }
typedef __bf16 bf16x2_t __attribute__((ext_vector_type(2)));
__device__ __forceinline__ unsigned pk2(float lo, float hi) { f32x2 v = {lo, hi}; bf16x2_t b = __builtin_convertvector(v, bf16x2_t); return __builtin_bit_cast(unsigned, b); }
__device__ __forceinline__ float bf2f(unsigned short b) { return __builtin_bit_cast(float, (unsigned)b << 16); }
__device__ __forceinline__ float bflo(unsigned w) { return __builtin_bit_cast(float, w << 16); }
__device__ __forceinline__ float bfhi(unsigned w) { return __builtin_bit_cast(float, w & 0xffff0000u); }
__device__ __forceinline__ float wave_sum(float v) {
#pragma unroll
    for (int o = 1; o < 64; o <<= 1) v += __shfl_xor(v, o);
    return v;
}
__device__ __forceinline__ float fast_exp2(float x) { return __builtin_amdgcn_exp2f(x); }
__device__ __forceinline__ float sigmoidf_(float x) { return __builtin_amdgcn_rcpf(1.0f + __builtin_amdgcn_exp2f(-LOG2E * x)); }
__device__ __forceinline__ u32x4 pair_swap_store(unsigned a0, unsigned a1, unsigned b0, unsigned b1) {
    auto r0 = __builtin_amdgcn_permlane32_swap(a0, b0, false, false); auto r1 = __builtin_amdgcn_permlane32_swap(a1, b1, false, false);
    return (u32x4){r0[0], r1[0], r0[1], r1[1]};
}
__device__ __forceinline__ float swap32_max(float v) { auto rr = __builtin_amdgcn_permlane32_swap(__float_as_uint(v), __float_as_uint(v), false, false); return fmaxf(__uint_as_float(rr[0]), __uint_as_float(rr[1])); }
__device__ __forceinline__ float swap32_sum(float v) { auto rr = __builtin_amdgcn_permlane32_swap(__float_as_uint(v), __float_as_uint(v), false, false); return __uint_as_float(rr[0]) + __uint_as_float(rr[1]); }
__device__ __forceinline__ s16x4 tr_read(LAS const unsigned char* p) { typedef short v4i16_t __attribute__((ext_vector_type(4))); return __builtin_bit_cast(s16x4, __builtin_amdgcn_ds_read_tr16_b64_v4i16((LAS v4i16_t*)p)); }
__device__ __forceinline__ bf16x8 pack8(const f32x16& p, int b) {
    u32x4 w; w.x = pk2(p[b], p[b + 1]); w.y = pk2(p[b + 2], p[b + 3]); w.z = pk2(p[b + 4], p[b + 5]); w.w = pk2(p[b + 6], p[b + 7]);
    return __builtin_bit_cast(bf16x8, w);
}
#define CR(r) (((r) & 3) + 8 * ((r) >> 2))
template <int CTRL> __device__ __forceinline__ int dpp_i(int v) { return __builtin_amdgcn_update_dpp(v, v, CTRL, 0xf, 0xf, false); }
template <int CTRL> __device__ __forceinline__ float dpp_f(float v) { return __int_as_float(__builtin_amdgcn_update_dpp(__float_as_int(v), __float_as_int(v), CTRL, 0xf, 0xf, false)); }
constexpr int DPP_XOR1 = 0xB1, DPP_XOR2 = 0x4E, DPP_HMIRROR = 0x141, DPP_ROR8 = 0x128;

namespace pg8 {
constexpr int BM = 256, BK = 64, HALF = 128, HTB = HALF * BK * 2, STAGE_BYTES = 8 * HTB, NXCD = 8, WGM = 8;
__host__ __device__ __forceinline__ int lds_byte(int r, int c) { const int st = (r >> 4) * 2 + (c >> 5), rr = r & 15, cc = c & 31, ob = rr * 64 + cc * 2; return st * 1024 + (ob ^ (((ob >> 9) & 1) << 5)); }
__host__ __device__ __forceinline__ void stage_rc(int b, int& R, int& C) { const int st = b / 1024, sb = b % 1024, swz = sb ^ (((sb >> 9) & 1) << 5); R = (st >> 1) * 16 + swz / 64; C = (st & 1) * 32 + (swz % 64) / 2; }
__host__ __device__ __forceinline__ int perm32(int rho) { const int n = rho >> 4, i = rho & 15; return 8 * (i >> 2) + 4 * n + (i & 3); }

struct Unit { int arow; int bt; int x; int y; };
struct Gemm { const bf16_t* A; const bf16_t* Bt; int K; };

struct DenseSched {
    int nM, nN, nwg, G, c, bt0;
    __device__ void init(int M, int N, int G_, int c_, int bt0_ = 0) { nM = M / BM; nN = N / BM; nwg = nM * nN; G = G_; c = c_; bt0 = bt0_; }
    __device__ bool next(int i, Unit& u) const {
        const long L = (long)i * G + c; if (L >= nwg) return false;
        int wgid = (int)L; { const int q = nwg / NXCD, r = nwg % NXCD, xcd = wgid % NXCD, off = wgid / NXCD; wgid = (xcd < r ? xcd * (q + 1) : r * (q + 1) + (xcd - r) * q) + off; }
        const int nig = WGM * nN, gid = wgid / nig, fm = gid * WGM, gsz = (nM - fm) < WGM ? (nM - fm) : WGM;
        const int pm = fm + ((wgid % nig) % gsz), pn = (wgid % nig) / gsz;
        u.arow = pm * BM; u.bt = bt0 + pn; u.x = pm; u.y = pn; return true;
    }
    __device__ __forceinline__ int row(const Unit&, int) const { return 0; }
};
struct ExpertSched {
    const LAS int* tstart; const LAS int* astart; const LAS unsigned char* texp; const int* rowslot; int ntile, npn, btmul, btadd, G, c;
    __device__ bool next(int i, Unit& u) const {
        const int per = G >> 3; const int L = (G & 7) ? i * G + c : ((i * 8 + (c & 7)) * per + (c >> 3)); if (L >= ntile * npn) return false;
        const int mtg = L / npn, pn = L - mtg * npn; const int e = texp[mtg];
        const int mt = mtg - tstart[e];
        u.x = e; u.y = mt | (pn << 16); u.bt = e * btmul + btadd + pn; u.arow = astart[e] + 256 * mt; return true;
    }
    __device__ __forceinline__ int row(const Unit& u, int r) const {
        const int e = u.x, cnt = astart[e + 1] - astart[e]; int pos = 256 * (u.y & 0xffff) + r; pos = pos < cnt ? pos : cnt - 1;
        return e < 64 ? (rowslot[(size_t)e * CAP + pos] >> 3) : pos;
    }
};

#ifndef PG8_SP2
#define PG8_SP2 true
#endif
template <class Epi, class Sched, bool GATHER, bool SP2 = PG8_SP2>
__device__ __forceinline__ void gemm_phase(LAS unsigned char* lds, const Gemm g, const Sched& S, const Epi& E) {
    int tid_ = threadIdx.x; asm volatile("" : "+v"(tid_));
    const int tid = tid_, wid = __builtin_amdgcn_readfirstlane(tid >> 6), lane = tid & 63, wr = wid >> 2, wc = wid & 3, fr = lane & 15, fq = lane >> 4;
    const int K = g.K, nt = K / BK;
    int Rr[2], Cc[2]; unsigned voffB[2], oc[2][2], on[2][2];
#pragma unroll
    for (int i = 0; i < 2; ++i) { int R, C; stage_rc(tid * 16 + i * 8192, R, C); Rr[i] = R; Cc[i] = C; const int Rb = Epi::PERM ? ((R & ~31) + perm32(R & 31)) : R;
        voffB[i] = (unsigned)(Rb * K + C) * 2u; }
    const unsigned kstep = (unsigned)(BK * 2);
    const unsigned hstep = (unsigned)(HALF * K * 2);
    const unsigned tstep = 2u * hstep;
    const __amdgpu_buffer_rsrc_t rsA = __builtin_amdgcn_make_buffer_rsrc((void*)g.A, 0, 0x7fffffff, 0x00020000), rsB = __builtin_amdgcn_make_buffer_rsrc((void*)g.Bt, 0, 0x7fffffff, 0x00020000);
    const unsigned ldsw = (unsigned)wid * 1024u;
    const int aoff = lds_byte(wr * 64 + fr, fq * 8), boff = lds_byte(wc * 32 + fr, fq * 8);
#define PG8_SA(b, h) (((b) * 2 + (h)) * HTB)
#define PG8_SB(b, h) ((4 + (b) * 2 + (h)) * HTB)
#define PG8_STAGE_(rs, bufoff, soff, voff) do { _Pragma("unroll") for (int _i = 0; _i < 2; ++_i) \
        __builtin_amdgcn_raw_ptr_buffer_load_lds(rs, (LAS void*)(lds + (bufoff) + ldsw + _i * 8192), 16, (voff)[_i], (soff), 0, 0); } while (0)
#define PG8_STAGE_A(bufoff, soff, voff) PG8_STAGE_(rsA, bufoff, soff, voff)
#define PG8_STAGE_B(bufoff, soff, voff) PG8_STAGE_(rsB, bufoff, soff, voff)
#define PG8_LDA(dst, b, h) do { _Pragma("unroll") for (int m = 0; m < 4; ++m) _Pragma("unroll") for (int k = 0; k < 2; ++k) dst[m][k] = *(const LAS bf16x8*)(lds + PG8_SA(b, h) + aoff + m * 2048 + k * 1024); } while (0)
#define PG8_LDB(dst, b, h) do { _Pragma("unroll") for (int n = 0; n < 2; ++n) _Pragma("unroll") for (int k = 0; k < 2; ++k) dst[n][k] = *(const LAS bf16x8*)(lds + PG8_SB(b, h) + boff + n * 2048 + k * 1024); } while (0)
#define PG8_MMA(ai, bj, At, Bt) do { __builtin_amdgcn_s_setprio(1); _Pragma("unroll") for (int m = 0; m < 4; ++m) _Pragma("unroll") for (int n = 0; n < 2; ++n) _Pragma("unroll") for (int k = 0; k < 2; ++k) \
        acc[ai][bj][m][n] = __builtin_amdgcn_mfma_f32_16x16x32_bf16(Bt[n][k], At[m][k], acc[ai][bj][m][n], 0, 0, 0); __builtin_amdgcn_s_setprio(0); } while (0)
#define PG8_WAIT_V(n) asm volatile("s_waitcnt vmcnt(" #n ")" ::: "memory")
#define PG8_WAIT_L(n) asm volatile("s_waitcnt lgkmcnt(" #n ")" ::: "memory")
#define PG8_BAR __builtin_amdgcn_s_barrier()
#define PG8_SCHED __builtin_amdgcn_sched_barrier(0)
#define PG8_OFFS(dst, u) do { _Pragma("unroll") for (int h = 0; h < 2; ++h) _Pragma("unroll") for (int i = 0; i < 2; ++i) \
        dst[h][i] = GATHER ? (unsigned)((unsigned)S.row(u, 128 * h + Rr[i]) * (unsigned)K + (unsigned)Cc[i]) * 2u : (unsigned)((128 * h + Rr[i]) * K + Cc[i]) * 2u; } while (0)
    Unit cur, nxt; int ui = 0;
    if (!S.next(0, cur)) return;
    f32x4 acc[2][2][4][2];
#pragma unroll
    for (int a = 0; a < 2; ++a)
#pragma unroll
        for (int b = 0; b < 2; ++b)
#pragma unroll
            for (int m = 0; m < 4; ++m)
#pragma unroll
                for (int n = 0; n < 2; ++n) acc[a][b][m][n] = (f32x4){0.f, 0.f, 0.f, 0.f};
    bf16x8 At[4][2], B0[2][2], B1[2][2];
    typename Epi::Pre pre; E.prefetch(pre, cur, wr, fr);
    PG8_OFFS(oc, cur);
    unsigned cA = GATHER ? 0u : (unsigned)cur.arow * (unsigned)K * 2u, cB = (unsigned)cur.bt * tstep;
    if constexpr (SP2) {
    PG8_STAGE_B(PG8_SB(0, 0), cB, voffB); PG8_STAGE_B(PG8_SB(0, 1), cB + hstep, voffB); PG8_STAGE_A(PG8_SA(0, 0), cA, oc[0]); PG8_STAGE_A(PG8_SA(0, 1), cA, oc[1]);
    if (wr == 1) PG8_BAR;
    PG8_WAIT_V(2); PG8_BAR;
    PG8_STAGE_B(PG8_SB(1, 0), cB + kstep, voffB); PG8_STAGE_A(PG8_SA(1, 0), cA + kstep, oc[0]); PG8_STAGE_B(PG8_SB(1, 1), cB + hstep + kstep, voffB);
    PG8_WAIT_V(6); PG8_BAR;
    } else {
    PG8_STAGE_B(PG8_SB(0, 0), cB, voffB); PG8_STAGE_A(PG8_SA(0, 0), cA, oc[0]); PG8_STAGE_B(PG8_SB(0, 1), cB + hstep, voffB); PG8_STAGE_A(PG8_SA(0, 1), cA, oc[1]);
    if (wr == 1) PG8_BAR;
    PG8_WAIT_V(4); PG8_BAR;
    PG8_STAGE_B(PG8_SB(1, 0), cB + kstep, voffB); PG8_STAGE_A(PG8_SA(1, 0), cA + kstep, oc[0]); PG8_STAGE_B(PG8_SB(1, 1), cB + hstep + kstep, voffB);
    PG8_WAIT_V(6); PG8_BAR;
    }
    for (;;) {
        const bool has_next = S.next(ui + 1, nxt);
        const unsigned nA = has_next ? (GATHER ? 0u : (unsigned)nxt.arow * (unsigned)K * 2u) : cA, nB = has_next ? (unsigned)nxt.bt * tstep : cB;
        if (GATHER) { if (has_next) { PG8_OFFS(on, nxt); } else {
#pragma unroll
            for (int h = 0; h < 2; ++h)
#pragma unroll
                for (int i = 0; i < 2; ++i) on[h][i] = oc[h][i]; } }
#pragma unroll 1
        for (int t = 0; t < nt; t += 2) {
            const bool last = (t == nt - 2);
            const unsigned a1 = cA + (unsigned)(t + 1) * kstep;
            const unsigned a2 = last ? nA : cA + (unsigned)(t + 2) * kstep, b2 = last ? nB : cB + (unsigned)(t + 2) * kstep;
            const unsigned a3 = a2 + kstep, b3 = b2 + kstep;
            unsigned o2[2][2];
#pragma unroll
            for (int h = 0; h < 2; ++h)
#pragma unroll
                for (int i = 0; i < 2; ++i) o2[h][i] = (GATHER && last) ? on[h][i] : oc[h][i];
            if constexpr (SP2) {
            PG8_LDB(B0, 0, 0); PG8_LDB(B1, 0, 1); PG8_SCHED; PG8_LDA(At, 0, 0); PG8_STAGE_A(PG8_SA(1, 1), a1, oc[1]);
            PG8_WAIT_V(8); PG8_WAIT_L(0); PG8_BAR; PG8_MMA(0, 0, At, B0); PG8_MMA(0, 1, At, B1); PG8_BAR; PG8_SCHED;
            PG8_LDA(At, 0, 1); PG8_STAGE_B(PG8_SB(0, 0), b2, voffB); PG8_STAGE_B(PG8_SB(0, 1), b2 + hstep, voffB); PG8_STAGE_A(PG8_SA(0, 0), a2, o2[0]);
            PG8_WAIT_V(8); PG8_WAIT_L(0); PG8_BAR; PG8_MMA(1, 0, At, B0); PG8_MMA(1, 1, At, B1); PG8_BAR; PG8_SCHED;
            PG8_LDB(B0, 1, 0); PG8_LDB(B1, 1, 1); PG8_SCHED; PG8_LDA(At, 1, 0); PG8_STAGE_A(PG8_SA(0, 1), a2, o2[1]);
            PG8_WAIT_V(8); PG8_WAIT_L(0); PG8_BAR; PG8_MMA(0, 0, At, B0); PG8_MMA(0, 1, At, B1); PG8_BAR; PG8_SCHED;
            PG8_LDA(At, 1, 1); PG8_STAGE_B(PG8_SB(1, 0), b3, voffB); PG8_STAGE_B(PG8_SB(1, 1), b3 + hstep, voffB); PG8_STAGE_A(PG8_SA(1, 0), a3, o2[0]);
            PG8_WAIT_V(8); PG8_WAIT_L(0); PG8_BAR; PG8_MMA(1, 0, At, B0); PG8_MMA(1, 1, At, B1); PG8_BAR; PG8_SCHED;
                    } else {
            PG8_LDB(B0, 0, 0); PG8_SCHED; PG8_LDA(At, 0, 0); PG8_STAGE_A(PG8_SA(1, 1), a1, oc[1]);
            PG8_WAIT_L(8); PG8_BAR; PG8_WAIT_L(0); PG8_MMA(0, 0, At, B0); PG8_BAR; PG8_SCHED;
            PG8_LDB(B1, 0, 1); PG8_STAGE_B(PG8_SB(0, 0), b2, voffB);
            PG8_BAR; PG8_WAIT_L(0); PG8_MMA(0, 1, At, B1); PG8_BAR;
            PG8_LDA(At, 0, 1); PG8_STAGE_A(PG8_SA(0, 0), a2, o2[0]);
            PG8_BAR; PG8_WAIT_L(0); PG8_MMA(1, 0, At, B0); PG8_BAR; PG8_SCHED;
            PG8_STAGE_B(PG8_SB(0, 1), b2 + hstep, voffB);
            PG8_WAIT_V(6); PG8_BAR; PG8_MMA(1, 1, At, B1); PG8_BAR;
            PG8_LDB(B0, 1, 0); PG8_SCHED; PG8_LDA(At, 1, 0); PG8_STAGE_A(PG8_SA(0, 1), a2, o2[1]);
            PG8_WAIT_L(8); PG8_BAR; PG8_WAIT_L(0); PG8_MMA(0, 0, At, B0); PG8_BAR; PG8_SCHED;
            PG8_LDB(B1, 1, 1); PG8_STAGE_B(PG8_SB(1, 0), b3, voffB);
            PG8_BAR; PG8_WAIT_L(0); PG8_MMA(0, 1, At, B1); PG8_BAR;
            PG8_LDA(At, 1, 1); PG8_STAGE_A(PG8_SA(1, 0), a3, o2[0]);
            PG8_BAR; PG8_WAIT_L(0); PG8_MMA(1, 0, At, B0); PG8_BAR; PG8_SCHED;
            PG8_STAGE_B(PG8_SB(1, 1), b3 + hstep, voffB);
            PG8_WAIT_V(6); PG8_BAR; PG8_MMA(1, 1, At, B1); PG8_BAR;
            }
        }
        if (wr == 0) PG8_BAR;
        E(acc, cur, wr, wc, fr, fq, pre);
        if (!has_next) break;
#pragma unroll
        for (int a = 0; a < 2; ++a)
#pragma unroll
            for (int b = 0; b < 2; ++b)
#pragma unroll
                for (int m = 0; m < 4; ++m)
#pragma unroll
                    for (int n = 0; n < 2; ++n) acc[a][b][m][n] = (f32x4){0.f, 0.f, 0.f, 0.f};
        cur = nxt; cA = nA; cB = nB; ++ui;
        E.prefetch(pre, cur, wr, fr);
#pragma unroll
        for (int h = 0; h < 2; ++h)
#pragma unroll
            for (int i = 0; i < 2; ++i) oc[h][i] = GATHER ? on[h][i] : oc[h][i];
        if (wr == 1) PG8_BAR;
    }
    PG8_WAIT_V(0);
    PG8_BAR;
#undef PG8_SA
#undef PG8_SB
#undef PG8_STAGE_
#undef PG8_STAGE_A
#undef PG8_STAGE_B
#undef PG8_LDA
#undef PG8_LDB
#undef PG8_MMA
#undef PG8_WAIT_V
#undef PG8_WAIT_L
#undef PG8_BAR
#undef PG8_SCHED
#undef PG8_OFFS
}
}
using pg8::Unit;
typedef f32x4 AccT[2][2][4][2];

struct EpiProj {
    static constexpr bool PERM = true;
    struct Pre {}; __device__ __forceinline__ void prefetch(Pre&, const Unit&, int, int) const {}
    bf16_t* proj; bf16_t* gates; float* nsag;
    __device__ __forceinline__ void operator()(const AccT& acc, const Unit& u, int wr, int wc, int fr, int fq, const Pre& pre) const {
        const int pn = u.y, row0 = u.arow + wr * 64 + fr;
        if (pn == 25) {
            if (wc == 0 && fq < 3) {
#pragma unroll
                for (int ai = 0; ai < 2; ++ai)
#pragma unroll
                    for (int m = 0; m < 4; ++m) { float* o = nsag + (size_t)(row0 + ai * 128 + m * 16) * 24 + 8 * fq;
                        const f32x4 v0 = acc[ai][0][m][0], v1 = acc[ai][0][m][1];
                        *(f32x4*)o = (f32x4){sigmoidf_(v0[0]), sigmoidf_(v0[1]), sigmoidf_(v0[2]), sigmoidf_(v0[3])};
                        *(f32x4*)(o + 4) = (f32x4){sigmoidf_(v1[0]), sigmoidf_(v1[1]), sigmoidf_(v1[2]), sigmoidf_(v1[3])}; }
            }
            return;
        }
        const bool gate = pn >= 17;
        const float sc = (pn < 4 || pn == 12 || pn == 13) ? QSCALE : 1.0f;
        bf16_t* base = gate ? gates : proj; const int ldc = gate ? 2048 : PROJ_W; const int col0 = (gate ? (pn - 17) : pn) * 256 + wc * 32 + 8 * fq;
#pragma unroll
        for (int ai = 0; ai < 2; ++ai)
#pragma unroll
            for (int m = 0; m < 4; ++m) { bf16_t* rowp = base + (size_t)(row0 + ai * 128 + m * 16) * ldc + col0;
#pragma unroll
                for (int bj = 0; bj < 2; ++bj) { f32x4 v0 = acc[ai][bj][m][0], v1 = acc[ai][bj][m][1];
                    if (gate) {
#pragma unroll
                        for (int j = 0; j < 4; ++j) { v0[j] = sigmoidf_(v0[j]); v1[j] = sigmoidf_(v1[j]); } }
                    else { v0 = v0 * sc; v1 = v1 * sc; }
                    u32x4 w; w.x = pk2(v0[0], v0[1]); w.y = pk2(v0[2], v0[3]); w.z = pk2(v1[0], v1[1]); w.w = pk2(v1[2], v1[3]);
                    __builtin_nontemporal_store(w, (u32x4*)(rowp + bj * 128)); } }
    }
};
template <bool ADD> struct EpiGate {
    static constexpr bool PERM = true;
    struct Pre {}; __device__ __forceinline__ void prefetch(Pre&, const Unit&, int, int) const {}
    bf16_t* merged; const bf16_t* gates; int goff;
    __device__ __forceinline__ void operator()(const AccT& acc, const Unit& u, int wr, int wc, int fr, int fq, const Pre& pre) const {
        const int row0 = u.arow + wr * 64 + fr, col0 = u.y * 256 + wc * 32 + 8 * fq;
#pragma unroll
        for (int ai = 0; ai < 2; ++ai)
#pragma unroll
            for (int m = 0; m < 4; ++m) { const size_t r = (size_t)(row0 + ai * 128 + m * 16);
#pragma unroll
                for (int bj = 0; bj < 2; ++bj) { const int c = col0 + bj * 128;
                    const u32x4 gv = *(const u32x4*)(gates + r * 2048 + goff + c);
                    f32x4 v0 = acc[ai][bj][m][0], v1 = acc[ai][bj][m][1];
                    v0[0] *= bflo(gv.x); v0[1] *= bfhi(gv.x); v0[2] *= bflo(gv.y); v0[3] *= bfhi(gv.y);
                    v1[0] *= bflo(gv.z); v1[1] *= bfhi(gv.z); v1[2] *= bflo(gv.w); v1[3] *= bfhi(gv.w);
                    if (ADD) { const u32x4 pv = *(const u32x4*)(merged + r * DM + c);
                        v0[0] += bflo(pv.x); v0[1] += bfhi(pv.x); v0[2] += bflo(pv.y); v0[3] += bfhi(pv.y);
                        v1[0] += bflo(pv.z); v1[1] += bfhi(pv.z); v1[2] += bflo(pv.w); v1[3] += bfhi(pv.w); }
                    u32x4 w; w.x = pk2(v0[0], v0[1]); w.y = pk2(v0[2], v0[3]); w.z = pk2(v1[0], v1[1]); w.w = pk2(v1[2], v1[3]);
                    *(u32x4*)(merged + r * DM + c) = w; } }
    }
};
struct EpiResid {
    static constexpr bool PERM = false;
    struct Pre {}; __device__ __forceinline__ void prefetch(Pre&, const Unit&, int, int) const {}
    const float* x; const float* mod; float* out; float* ssq;
    __device__ __forceinline__ void operator()(const AccT& acc, const Unit& u, int wr, int wc, int fr, int fq, const Pre& pre) const {
        const int row0 = u.arow + wr * 64 + fr, col0 = u.y * 256 + wc * 32 + 4 * fq; const int b = u.arow / SEQ;
        const float* g1 = mod + (size_t)b * 6144 + 2048;
        float sq[2][4];
#pragma unroll
        for (int ai = 0; ai < 2; ++ai)
#pragma unroll
            for (int m = 0; m < 4; ++m) sq[ai][m] = 0.f;
#pragma unroll
        for (int bj = 0; bj < 2; ++bj)
#pragma unroll
            for (int n = 0; n < 2; ++n) { const int c = col0 + bj * 128 + n * 16; const f32x4 gv = *(const f32x4*)(g1 + c);
#pragma unroll
                for (int ai = 0; ai < 2; ++ai)
#pragma unroll
                    for (int m = 0; m < 4; ++m) { const size_t off = (size_t)(row0 + ai * 128 + m * 16) * DM + c;
                        const f32x4 xv = *(const f32x4*)(x + off); const f32x4 o = xv + gv * acc[ai][bj][m][n]; *(f32x4*)(out + off) = o;
                        sq[ai][m] += (o.x * o.x + o.y * o.y) + (o.z * o.z + o.w * o.w); } }
        float* sp = ssq + (size_t)(u.y * 4 + wc) * NTOK + row0;
#pragma unroll
        for (int ai = 0; ai < 2; ++ai)
#pragma unroll
            for (int m = 0; m < 4; ++m) { float t = sq[ai][m]; t += __shfl_xor(t, 16); t += __shfl_xor(t, 32); if (fq == 0) sp[ai * 128 + m * 16] = t; }
    }
};
struct EpiAct {
    static constexpr bool PERM = true;
    struct Pre {}; __device__ __forceinline__ void prefetch(Pre&, const Unit&, int, int) const {}
    bf16_t* act; const LAS int* astart;
    __device__ __forceinline__ void operator()(const AccT& acc, const Unit& u, int wr, int wc, int fr, int fq, const Pre& pre) const {
        const int e = u.x, mt = u.y & 0xffff, pn = u.y >> 16, rbase = u.arow, nvalid = (astart[e + 1] - astart[e]) - 256 * mt;
        const int col0 = pn * 128 + wc * 32 + 8 * fq;
#pragma unroll
        for (int ai = 0; ai < 2; ++ai)
#pragma unroll
            for (int m = 0; m < 4; ++m) { const int lr = ai * 128 + wr * 64 + m * 16 + fr;
                if (lr < nvalid) {
                    const f32x4 g0 = acc[ai][0][m][0], g1 = acc[ai][0][m][1], u0 = acc[ai][1][m][0], u1 = acc[ai][1][m][1]; float a[8];
#pragma unroll
                    for (int j = 0; j < 4; ++j) { a[j] = g0[j] * sigmoidf_(g0[j]) * u0[j]; a[4 + j] = g1[j] * sigmoidf_(g1[j]) * u1[j]; }
                    u32x4 w; w.x = pk2(a[0], a[1]); w.y = pk2(a[2], a[3]); w.z = pk2(a[4], a[5]); w.w = pk2(a[6], a[7]);
                    *(u32x4*)(act + (size_t)(rbase + lr) * EH + col0) = w; } }
    }
};
struct EpiDown {
    static constexpr bool PERM = true;
    struct Pre {}; __device__ __forceinline__ void prefetch(Pre&, const Unit&, int, int) const {}
    bf16_t* Y; const LAS int* astart;
    __device__ __forceinline__ void operator()(const AccT& acc, const Unit& u, int wr, int wc, int fr, int fq, const Pre& pre) const {
        const int e = u.x, mt = u.y & 0xffff, pn = u.y >> 16; const int nvalid = (astart[e + 1] - astart[e]) - 256 * mt;
        const int col0 = pn * 256 + wc * 32 + 8 * fq;
#pragma unroll
        for (int ai = 0; ai < 2; ++ai)
#pragma unroll
            for (int m = 0; m < 4; ++m) { const int lr = ai * 128 + wr * 64 + m * 16 + fr;
                if (lr < nvalid) {
                    bf16_t* rowp = Y + (size_t)(u.arow + lr) * YW + col0;
#pragma unroll
                    for (int bj = 0; bj < 2; ++bj) { const f32x4 v0 = acc[ai][bj][m][0], v1 = acc[ai][bj][m][1];
                        u32x4 o; o.x = pk2(v0[0], v0[1]); o.y = pk2(v0[2], v0[3]); o.z = pk2(v1[0], v1[1]); o.w = pk2(v1[2], v1[3]);
                        *(u32x4*)(rowp + bj * 128) = o; } } }
    }
};

#define XB_TMO      128
#define XB_XCNT(j)  (256  + 64 * (j))
#define XB_XSUB(j)  (1280 + 64 * (j))
#define XB_XGEN(j)  (2304 + 64 * (j))
#define XB_TOP      3328
#define XB_TOPGEN   3392
#define XCD_BAR_WORDS 3456
#define XB_SPIN_CAP (1u << 23)
__device__ __forceinline__ unsigned xb_ld(unsigned* p)              { return __hip_atomic_load(p, __ATOMIC_RELAXED, __HIP_MEMORY_SCOPE_AGENT); }
__device__ __forceinline__ unsigned xb_add(unsigned* p, unsigned v) { return __hip_atomic_fetch_add(p, v, __ATOMIC_RELAXED, __HIP_MEMORY_SCOPE_AGENT); }
__device__ __forceinline__ unsigned xb_xcc_id() { return (unsigned)__builtin_amdgcn_s_getreg((3 << 11) | 20) & 0xFu; }
#define XB_SPIN(cond, bar) do { unsigned _sp = 0; while (cond) { __builtin_amdgcn_s_sleep(1); \
    if ((++_sp & 255u) == 0u) { if (xb_ld(&(bar)[XB_TMO])) break; if (_sp > XB_SPIN_CAP) { atomicAdd(&(bar)[XB_TMO], 1u); break; } } } } while (0)
struct XcdBarrier { unsigned* bar; unsigned x; volatile LAS unsigned* st; };
__device__ __forceinline__ XcdBarrier xcd_barrier_post(unsigned* bar, volatile LAS unsigned* st) {
    XcdBarrier b; b.bar = bar; b.x = xb_xcc_id(); b.st = st;
    if (threadIdx.x == 0) (void)xb_add(&bar[XB_XCNT(b.x)], 1u);
    return b;
}
__device__ __forceinline__ void xcd_barrier_complete(unsigned* bar, unsigned x, unsigned& nloc, unsigned& nx) {
    const unsigned G = gridDim.x * gridDim.y * gridDim.z;
    unsigned sum, cnt, mine, sp = 0u;
    for (;;) {
        sum = 0u; cnt = 0u; mine = 0u;
#pragma unroll
        for (unsigned j = 0; j < 16; ++j) { const unsigned c = xb_ld(&bar[XB_XCNT(j)]); sum += c; cnt += (c > 0u) ? 1u : 0u; mine = (j == x) ? c : mine; }
        if (sum == G) break;
        __builtin_amdgcn_s_sleep(1);
        if ((++sp & 255u) == 0u) { if (xb_ld(&bar[XB_TMO])) break; if (sp > XB_SPIN_CAP) { atomicAdd(&bar[XB_TMO], 1u); break; } }
    }
    nloc = mine > 0u ? mine : 1u; nx = cnt > 0u ? cnt : 1u;
}
__device__ __forceinline__ void xcd_barrier(const XcdBarrier& b) {
    asm volatile("s_waitcnt vmcnt(0)" ::: "memory");
    __syncthreads();
    if (threadIdx.x == 0) {
        unsigned* bar = b.bar;
        __builtin_amdgcn_s_waitcnt(0);
        unsigned nloc = b.st[0], nx = b.st[1];
        if (nloc == 0u) { xcd_barrier_complete(bar, b.x, nloc, nx); b.st[0] = nloc; b.st[1] = nx; }
        const unsigned old = xb_add(&bar[XB_XSUB(b.x)], 1u);
        const unsigned gen = old / nloc;
        if (old + 1u == (gen + 1u) * nloc) {
            __builtin_amdgcn_fence(__ATOMIC_RELEASE, "agent");
            asm volatile("s_waitcnt vmcnt(0)" ::: "memory");
            const unsigned og = xb_add(&bar[XB_TOP], 1u);
            const unsigned tg = og / nx;
            if (og + 1u == (tg + 1u) * nx) xb_add(&bar[XB_TOPGEN], 1u);
            else XB_SPIN(xb_ld(&bar[XB_TOPGEN]) == tg, bar);
            __builtin_amdgcn_fence(__ATOMIC_ACQUIRE, "agent");
            xb_add(&bar[XB_XGEN(b.x)], 1u);
            asm volatile("s_waitcnt vmcnt(0)" ::: "memory");
        } else {
            XB_SPIN(xb_ld(&bar[XB_XGEN(b.x)]) == gen, bar);
            __builtin_amdgcn_fence(__ATOMIC_ACQUIRE, "agent");
            asm volatile("s_waitcnt vmcnt(0)" ::: "memory");
        }
    }
    __syncthreads();
}

struct Ctx {
    LAS unsigned char* lds; int tid, lane, wave, G, bid;
    const float* in[30]; float* out; unsigned char* ws;
    __device__ __forceinline__ const float* gin(int k) const { return in[k]; }
};

__device__ __forceinline__ int dest_row(int mode, int n) {
    if (mode == 1) return n < 4352 ? n : (n < 4376 ? 6400 + (n - 4352) : 4352 + (n - 4376));
    if (mode == 2) return (n >> 7) * 256 + (n & 127);
    if (mode == 3) return (n >> 7) * 256 + 128 + (n & 127);
    return n;
}
__device__ __forceinline__ void transpose_item(const float* W, int K, int N, bf16_t* WT, int mode, LAS float* scr, int item, int lane) {
    const int nblk = (N + 31) / 32, kb = item / nblk, nb = item % nblk, k0 = 64 * kb, n0 = 32 * nb;
    const int nn = n0 + (lane & 31);
    float tv[32];
#pragma unroll
    for (int i = 0; i < 32; ++i) { const int kk = 2 * i + (lane >> 5); tv[i] = nn < N ? __builtin_nontemporal_load(W + (size_t)(k0 + kk) * N + nn) : 0.f; }
#pragma unroll
    for (int i = 0; i < 32; ++i) { const int kk = 2 * i + (lane >> 5); scr[kk * 33 + (lane & 31)] = tv[i]; }
    asm volatile("s_waitcnt lgkmcnt(0)" ::: "memory");
    const int c = lane & 7;
#pragma unroll
    for (int j = 0; j < 4; ++j) { const int n = (lane >> 3) + 8 * j; const LAS float* s = scr + (8 * c) * 33 + n;
        u32x4 o; o.x = pk2(s[0 * 33], s[1 * 33]); o.y = pk2(s[2 * 33], s[3 * 33]); o.z = pk2(s[4 * 33], s[5 * 33]); o.w = pk2(s[6 * 33], s[7 * 33]);
        if (n0 + n < N) *(u32x4*)(WT + (size_t)dest_row(mode, n0 + n) * K + k0 + 8 * c) = o; }
    asm volatile("s_waitcnt lgkmcnt(0)" ::: "memory");
}
__device__ __forceinline__ void router_item(const float* W, bf16_t* HI, bf16_t* LO, LAS float* scr, int item, int lane) {
    const int kb = item / 2, nb = item % 2, k0 = 64 * kb, n0 = 32 * nb;
#pragma unroll 8
    for (int i = 0; i < 32; ++i) { const int kk = 2 * i + (lane >> 5); scr[kk * 33 + (lane & 31)] = W[(size_t)(k0 + kk) * 64 + n0 + (lane & 31)]; }
    asm volatile("s_waitcnt lgkmcnt(0)" ::: "memory");
    const int c = lane & 7;
#pragma unroll
    for (int j = 0; j < 4; ++j) { const int n = (lane >> 3) + 8 * j; const LAS float* s = scr + (8 * c) * 33 + n; unsigned h[8], l[8];
#pragma unroll
        for (int q = 0; q < 8; ++q) { const float v = s[q * 33]; h[q] = f2bf(v); l[q] = f2bf(v - __builtin_bit_cast(float, h[q] << 16)); }
        u32x4 oh, ol; oh.x = h[0] | (h[1] << 16); oh.y = h[2] | (h[3] << 16); oh.z = h[4] | (h[5] << 16); oh.w = h[6] | (h[7] << 16);
        ol.x = l[0] | (l[1] << 16); ol.y = l[2] | (l[3] << 16); ol.z = l[4] | (l[5] << 16); ol.w = l[6] | (l[7] << 16);
        const int e = n0 + n, kg = (k0 + 8 * c) >> 3; const size_t fo = (size_t)((((kg >> 4) * 4 + ((kg >> 2) & 3)) * 4 + (e >> 4)) * 2) * 512 + ((kg & 3) * 16 + (e & 15)) * 8;
        *(u32x4*)(HI + fo) = oh; *(u32x4*)(HI + fo + 512) = ol; }
    asm volatile("s_waitcnt lgkmcnt(0)" ::: "memory");
}
__device__ __forceinline__ void p0_prologue(const Ctx& C) {
    LAS float* scr = (LAS float*)(C.lds + C.wave * 16384);
    const int gw = C.bid * NWAVES + C.wave, NGW = C.G * NWAVES;
    unsigned char* ws = C.ws;
    constexpr int I_IN = 16 * 201, I_DA = 512, I_NSA = 256, I_O = 512, I_SG = 128, I_SU = 128, I_SD = 128,
                  I_K1 = 128, I_V1 = 128, I_K2 = 4, I_V2 = 4, I_R = 32, I_Z = 232;
    constexpr int NITEMS = I_IN + I_DA + I_NSA + I_O + I_SG + I_SU + I_SD + I_K1 + I_V1 + I_K2 + I_V2 + I_R + I_Z;
    for (int it = gw; it < NITEMS; it += NGW) {
        int r = it;
        if (r < I_IN) { transpose_item(C.gin(5), 1024, 6424, (bf16_t*)(ws + WS_WIN), 1, scr, r, C.lane); continue; } r -= I_IN;
        if (r < I_DA) { transpose_item(C.gin(17), 1024, 1024, (bf16_t*)(ws + WS_WDA), 0, scr, r, C.lane); continue; } r -= I_DA;
        if (r < I_NSA) { transpose_item(C.gin(18), 512, 1024, (bf16_t*)(ws + WS_WNSA), 0, scr, r, C.lane); continue; } r -= I_NSA;
        if (r < I_O) { transpose_item(C.gin(19), 1024, 1024, (bf16_t*)(ws + WS_WO), 0, scr, r, C.lane); continue; } r -= I_O;
        if (r < I_SG) { transpose_item(C.gin(26), 1024, 256, (bf16_t*)(ws + WS_SHGU), 2, scr, r, C.lane); continue; } r -= I_SG;
        if (r < I_SU) { transpose_item(C.gin(27), 1024, 256, (bf16_t*)(ws + WS_SHGU), 3, scr, r, C.lane); continue; } r -= I_SU;
        if (r < I_SD) { transpose_item(C.gin(28), 256, 1024, (bf16_t*)(ws + WS_SHDN), 0, scr, r, C.lane); continue; } r -= I_SD;
        if (r < I_K1) { transpose_item(C.gin(12), 2048, 128, (bf16_t*)(ws + WS_CKW1), 0, scr, r, C.lane); continue; } r -= I_K1;
        if (r < I_V1) { transpose_item(C.gin(15), 2048, 128, (bf16_t*)(ws + WS_CVW1), 0, scr, r, C.lane); continue; } r -= I_V1;
        if (r < I_K2) { transpose_item(C.gin(13), 128, 64, (bf16_t*)(ws + WS_CKW2), 0, scr, r, C.lane); continue; } r -= I_K2;
        if (r < I_V2) { transpose_item(C.gin(16), 128, 64, (bf16_t*)(ws + WS_CVW2), 0, scr, r, C.lane); continue; } r -= I_V2;
        if (r < I_R) { router_item(C.gin(21), (bf16_t*)(ws + WS_RHI), (bf16_t*)(ws + WS_RLO), scr, r, C.lane); continue; } r -= I_R;
        { u32x4* z = (u32x4*)((bf16_t*)(ws + WS_WIN) + (size_t)(6424 + r) * 1024); z[C.lane] = (u32x4){0u, 0u, 0u, 0u}; z[64 + C.lane] = (u32x4){0u, 0u, 0u, 0u}; }
    }
    __syncthreads();
    LAS float* red = (LAS float*)C.lds;
    LAS float* cact = (LAS float*)(C.lds + 16384);
    for (int i = C.tid; i < 4096; i += NTHREADS) { const float cv = C.gin(1)[i]; cact[i] = cv * sigmoidf_(cv); }
    __syncthreads();
    for (int cg0 = C.bid * 24; cg0 < 6144; cg0 += C.G * 24) {
        const int cl = C.tid & 31, kp = C.tid >> 5; float a0 = 0.f, a1 = 0.f, a2 = 0.f, a3 = 0.f;
        if (cl < 24) {
            const float* cw = C.gin(2) + cg0 + cl;
            float wv[64];
#pragma unroll
            for (int k = 0; k < 64; ++k) wv[k] = cw[(size_t)(kp * 64 + k) * 6144];
#pragma unroll
            for (int k = 0; k < 64; ++k) { const int kk = kp * 64 + k; a0 += cact[kk] * wv[k]; a1 += cact[1024 + kk] * wv[k]; a2 += cact[2048 + kk] * wv[k]; a3 += cact[3072 + kk] * wv[k]; }
        }
        red[(kp * 32 + cl) * 4 + 0] = a0; red[(kp * 32 + cl) * 4 + 1] = a1; red[(kp * 32 + cl) * 4 + 2] = a2; red[(kp * 32 + cl) * 4 + 3] = a3;
        __syncthreads();
        if (C.tid < 96) { const int b = C.tid / 24, c2 = C.tid % 24; float s = 0.f;
            for (int k = 0; k < 16; ++k) s += red[(k * 32 + c2) * 4 + b];
            ((float*)(ws + WS_MOD))[b * 6144 + cg0 + c2] = s + C.gin(3)[cg0 + c2]; }
        __syncthreads();
    }
}

__device__ __forceinline__ void modulate_rows(const Ctx& C, const float* x, const float* nw, int sh_off, int sc_off, bf16_t* dst) {
    const int gw = C.bid * NWAVES + C.wave, NGW = C.G * NWAVES; const float* mod = (const float*)(C.ws + WS_MOD);
    for (int m = gw; m < NTOK; m += NGW) {
        const int b = m / SEQ; const f32x4* xr = (const f32x4*)(x + (size_t)m * DM) + C.lane;
        f32x4 v[4]; float s = 0.f;
#pragma unroll
        for (int j = 0; j < 4; ++j) { v[j] = xr[64 * j]; s += (v[j].x * v[j].x + v[j].y * v[j].y) + (v[j].z * v[j].z + v[j].w * v[j].w); }
        const float rstd = rsqrtf(wave_sum(s) * (1.f / DM) + 1e-6f);
        u32x2* o8 = (u32x2*)(dst + (size_t)m * DM) + C.lane;
#pragma unroll
        for (int j = 0; j < 4; ++j) { const f32x4 w = ((const f32x4*)nw)[64 * j + C.lane], sc = ((const f32x4*)(mod + b * 6144 + sc_off))[64 * j + C.lane], sh = ((const f32x4*)(mod + b * 6144 + sh_off))[64 * j + C.lane];
            const f32x4 y = v[j] * rstd * w * (sc + 1.0f) + sh; o8[64 * j] = (u32x2){pk2(y.x, y.y), pk2(y.z, y.w)}; }
    }
}

__device__ __forceinline__ float gelu_tanh(float x) { const float u = 0.7978845608028654f * (x + 0.044715f * x * x * x); const float e = __expf(2.f * u); return 0.5f * x * (1.f + (1.f - 2.f / (e + 1.f))); }
__device__ __forceinline__ void compress_phase(const Ctx& C) {
    const int lane = C.lane, wid = C.wave, fr = lane & 15, kq = lane >> 4;
    LAS bf16_t* H = (LAS bf16_t*)C.lds;
    LAS float* nrm = (LAS float*)(C.lds + 12288);
    for (int u = C.bid; u < 256; u += C.G) {
        const int kv = u >> 7, b = (u >> 5) & 3, g = (u >> 4) & 1, c0 = (u & 15) * 32;
        const bf16_t* P = (const bf16_t*)(C.ws + WS_PROJ) + (size_t)b * SEQ * PROJ_W + (kv ? C_CV : C_CK) + g * 64;
        const float* pe = C.gin(kv ? 14 : 11);
        const bf16_t* w1 = (const bf16_t*)(C.ws + (kv ? WS_CVW1 : WS_CKW1)) + (size_t)(16 * wid + fr) * 2048;
        f32x4 acc[2] = {(f32x4){0.f, 0.f, 0.f, 0.f}, (f32x4){0.f, 0.f, 0.f, 0.f}};
        int tokb[2];
#pragma unroll
        for (int mt = 0; mt < 2; ++mt) { int c = c0 + 16 * mt + fr; c = c < 511 ? c : 510; tokb[mt] = 16 * c; }
        for (int ks = 0; ks < 64; ++ks) {
            const int l = ks >> 1, d = 32 * (ks & 1) + 8 * kq;
            const bf16x8 bfrag = *(const bf16x8*)(w1 + 32 * ks + 8 * kq);
            const f32x4 p0 = *(const f32x4*)(pe + l * 64 + d), p1 = *(const f32x4*)(pe + l * 64 + d + 4);
#pragma unroll
            for (int mt = 0; mt < 2; ++mt) {
                const u32x4 xv = *(const u32x4*)(P + (size_t)(tokb[mt] + l) * PROJ_W + d);
                u32x4 av; av.x = pk2(bflo(xv.x) + p0[0], bfhi(xv.x) + p0[1]); av.y = pk2(bflo(xv.y) + p0[2], bfhi(xv.y) + p0[3]);
                av.z = pk2(bflo(xv.z) + p1[0], bfhi(xv.z) + p1[1]); av.w = pk2(bflo(xv.w) + p1[2], bfhi(xv.w) + p1[3]);
                acc[mt] = __builtin_amdgcn_mfma_f32_16x16x32_bf16(__builtin_bit_cast(bf16x8, av), bfrag, acc[mt], 0, 0, 0);
            }
        }
#pragma unroll
        for (int mt = 0; mt < 2; ++mt)
#pragma unroll
            for (int i = 0; i < 4; ++i) H[(16 * mt + 4 * kq + i) * 136 + 16 * wid + fr] = (bf16_t)f2bf(gelu_tanh(acc[mt][i]));
        __syncthreads();
        if (wid < 4) {
            const bf16_t* w2 = (const bf16_t*)(C.ws + (kv ? WS_CVW2 : WS_CKW2)) + (size_t)(16 * wid + fr) * 128;
            f32x4 o[2] = {(f32x4){0.f, 0.f, 0.f, 0.f}, (f32x4){0.f, 0.f, 0.f, 0.f}};
#pragma unroll
            for (int ks = 0; ks < 4; ++ks) { const bf16x8 bfrag = *(const bf16x8*)(w2 + 32 * ks + 8 * kq);
#pragma unroll
                for (int mt = 0; mt < 2; ++mt) { const bf16x8 afrag = *(const LAS bf16x8*)(H + (16 * mt + fr) * 136 + 32 * ks + 8 * kq);
                    o[mt] = __builtin_amdgcn_mfma_f32_16x16x32_bf16(afrag, bfrag, o[mt], 0, 0, 0); } }
            bf16_t* dst = (bf16_t*)(C.ws + (kv ? WS_VC : WS_KC)) + (size_t)(b * 2 + g) * 512 * 64;
#pragma unroll
            for (int mt = 0; mt < 2; ++mt)
#pragma unroll
                for (int i = 0; i < 4; ++i) { const int c = c0 + 16 * mt + 4 * kq + i; const unsigned hb = c < 511 ? f2bf(o[mt][i]) : 0u; dst[(size_t)c * 64 + 16 * wid + fr] = (bf16_t)hb;
                    float pq = bf2f((unsigned short)hb); pq *= pq; pq += __shfl_xor(pq, 1); pq += __shfl_xor(pq, 2); pq += __shfl_xor(pq, 4); pq += __shfl_xor(pq, 8);
                    if (fr == 0) nrm[(16 * mt + 4 * kq + i) * 4 + wid] = pq; }
        }
        __syncthreads();
        if (kv == 0 && C.tid < 32) { float v = sqrtf(nrm[C.tid * 4] + nrm[C.tid * 4 + 1] + nrm[C.tid * 4 + 2] + nrm[C.tid * 4 + 3]) * 1.001f;
#pragma unroll
            for (int o2 = 1; o2 < 32; o2 <<= 1) v = fmaxf(v, __shfl_xor(v, o2));
            if (C.tid == 0) atomicMax((unsigned*)(C.ws + WS_CTL) + CW_KCMAX + b * 2 + g, __float_as_uint(v)); }
    }
}

__device__ __forceinline__ void knorm_phase(const Ctx& C) {
    LAS float* red = (LAS float*)(C.lds + 16384);
    LAS float* red2 = (LAS float*)(C.lds + 16384 + 8192);
    for (int it = C.bid; it < 512; it += C.G) {
        const int b = it >> 7, t = it & 127, tok = C.tid >> 3, part = C.tid & 7;
        const u32x4* src = (const u32x4*)((const bf16_t*)(C.ws + WS_PROJ) + (size_t)(b * SEQ + 64 * t + tok) * PROJ_W + C_DAK + part * 128);
        float ss[2] = {0.f, 0.f};
#pragma unroll
        for (int cc = 0; cc < 2; ++cc)
#pragma unroll
            for (int i = 0; i < 8; ++i) { const u32x4 w = src[cc * 8 + i];
                ss[cc] += bflo(w.x) * bflo(w.x) + bfhi(w.x) * bfhi(w.x) + bflo(w.y) * bflo(w.y) + bfhi(w.y) * bfhi(w.y) + bflo(w.z) * bflo(w.z) + bfhi(w.z) * bfhi(w.z) + bflo(w.w) * bflo(w.w) + bfhi(w.w) * bfhi(w.w); }
        red[tok * 17 + part * 2] = ss[0]; red[tok * 17 + part * 2 + 1] = ss[1];
        if (part < 2) {
            const u32x4* sk = (const u32x4*)((const bf16_t*)(C.ws + WS_PROJ) + (size_t)(b * SEQ + 64 * t + tok) * PROJ_W + C_SK + part * 64); float sq = 0.f;
#pragma unroll
            for (int i = 0; i < 8; ++i) { const u32x4 w = sk[i];
                sq += bflo(w.x) * bflo(w.x) + bfhi(w.x) * bfhi(w.x) + bflo(w.y) * bflo(w.y) + bfhi(w.y) * bfhi(w.y) + bflo(w.z) * bflo(w.z) + bfhi(w.z) * bfhi(w.z) + bflo(w.w) * bflo(w.w) + bfhi(w.w) * bfhi(w.w); }
            red2[tok * 2 + part] = sq; }
        __syncthreads();
        if (C.tid >= 64 && C.tid < 128) { const int l2 = C.tid - 64, gcol = l2 & 1; float mx = fmaxf(red2[(l2 >> 1) * 2 + gcol], red2[(32 + (l2 >> 1)) * 2 + gcol]);
#pragma unroll
            for (int o2 = 2; o2 < 64; o2 <<= 1) mx = fmaxf(mx, __shfl_xor(mx, o2));
            if (l2 < 2) ((float*)(C.ws + WS_KSN))[((size_t)b * 2 + gcol) * 128 + t] = sqrtf(mx) * 1.001f; }
        if (C.tid < 64) { const int col = C.tid & 15, q4 = C.tid >> 4; float mx = 0.f;
#pragma unroll
            for (int k = 0; k < 16; ++k) mx = fmaxf(mx, red[(q4 * 16 + k) * 17 + col]);
            mx = fmaxf(mx, __shfl_xor(mx, 16)); mx = fmaxf(mx, __shfl_xor(mx, 32));
            if (C.tid < 16) ((float*)(C.ws + WS_KTN))[((size_t)b * 16 + C.tid) * 128 + t] = sqrtf(mx) * 1.001f; }
        __syncthreads();
    }
}

constexpr int DA_KB = 16384, DA_VSTR = 320, DA_VB = 64 * DA_VSTR;
constexpr int DA_LDS_K = 0, DA_LDS_V = 2 * DA_KB, DA_LDS_OS = DA_LDS_V + 2 * DA_VB;
constexpr int DA_LDS_KPM = DA_LDS_OS + 32768;
constexpr int DA_LDS_FLG = DA_LDS_KPM + 2048;
constexpr int ATT_LDS_Q = DA_LDS_FLG + 64;
__device__ __forceinline__ unsigned cvtpk(float lo, float hi) { return pk2(lo, hi); }
__device__ __forceinline__ bf16x8 pack8c(const f32x16& p, int b) { u32x4 w; w.x = cvtpk(p[b], p[b + 1]); w.y = cvtpk(p[b + 2], p[b + 3]); w.z = cvtpk(p[b + 4], p[b + 5]); w.w = cvtpk(p[b + 6], p[b + 7]); return __builtin_bit_cast(bf16x8, w); }
__device__ __forceinline__ void da_unit(const Ctx& C, int b, int h, int qb, float lam) {
    const int tid = C.tid, lane = C.lane, wid = C.wave, r32 = lane & 31, hi = lane >> 5, c = wid >> 2, wq = wid & 3;
    const bf16_t* P = (const bf16_t*)(C.ws + WS_PROJ) + (size_t)b * SEQ * PROJ_W;
    const int q0w = qb * 128 + wq * 32, tq = q0w + r32;
    const float slope2 = exp2f(-(float)(2 * h + 1) * 0.5f) * LOG2E;
    const float DA_THR = 25.5f - log2f(slope2 * 0.6931472f);
    const int NT = 2 * qb + 2, tmaxw = 2 * qb + (wq >> 1);
    LAS unsigned char* lds = C.lds;
    LAS unsigned* osv = (LAS unsigned*)(lds + DA_LDS_OS) + wq * 2048 + lane;
    LAS float* kraw = (LAS float*)(lds + DA_LDS_KPM); LAS float* kpm = kraw + 256; LAS int* flg = (LAS int*)(lds + DA_LDS_FLG);
    if (wid < 4) {
        const float* src = (const float*)(C.ws + WS_KTN) + ((size_t)(b * 8 + h) * 2 + (wid >> 1)) * 128;
        float v = src[(wid & 1) * 64 + lane];
#pragma unroll
        for (int o = 1; o < 64; o <<= 1) { const float u = __shfl_up(v, o); if (lane >= o) v = fmaxf(v, u); }
        if (wid & 1) { float t0 = src[lane];
#pragma unroll
            for (int o = 1; o < 64; o <<= 1) t0 = fmaxf(t0, __shfl_xor(t0, o));
            v = fmaxf(v, t0); }
        kpm[(wid >> 1) * 128 + (wid & 1) * 64 + lane] = v;
    }
    const int skey = tid >> 4, sch = tid & 15;
    const int kdst0 = (sch >> 3) * 8192 + skey * 128 + (((sch & 7) ^ ((skey >> 1) & 7)) << 4), kdst1 = kdst0 + 32 * 128;
    const int vdst0 = skey * DA_VSTR + sch * 16, vdst1 = vdst0 + 32 * DA_VSTR;
    const int vrd = (4 * hi + ((lane & 15) >> 2)) * DA_VSTR + (16 * ((lane >> 4) & 1) + 4 * (lane & 3)) * 2;
    bf16x8 qf[4];
#pragma unroll
    for (int d0 = 0; d0 < 4; ++d0) qf[d0] = *(const bf16x8*)(P + (size_t)tq * PROJ_W + C_DAQ + h * 128 + c * 64 + d0 * 16 + hi * 8);
    float qn;
    { float ss = 0.f;
#pragma unroll
      for (int d0 = 0; d0 < 4; ++d0) { const u32x4 w = __builtin_bit_cast(u32x4, qf[d0]);
          ss += bflo(w.x) * bflo(w.x) + bfhi(w.x) * bfhi(w.x) + bflo(w.y) * bflo(w.y) + bfhi(w.y) * bfhi(w.y) + bflo(w.z) * bflo(w.z) + bfhi(w.z) * bfhi(w.z) + bflo(w.w) * bflo(w.w) + bfhi(w.w) * bfhi(w.w); }
      qn = sqrtf(swap32_sum(ss)) * 1.001f; }
    f32x16 o[4];
#pragma unroll
    for (int d = 0; d < 4; ++d)
#pragma unroll
        for (int r = 0; r < 16; ++r) o[d][r] = 0.f;
    float m = 0.f, l = 0.f; bool first = true;
    const bf16_t* ksrc = P + (size_t)skey * PROJ_W + C_DAK + h * 128 + sch * 8;
    const bf16_t* vsrc = P + (size_t)skey * PROJ_W + C_DAV + h * 128 + sch * 8;
    u32x4 kreg0, kreg1, vreg0, vreg1;
    { const size_t adv = (size_t)(NT - 1) * 64 * PROJ_W; kreg0 = *(const u32x4*)(ksrc + adv); kreg1 = *(const u32x4*)(ksrc + adv + (size_t)32 * PROJ_W); vreg0 = *(const u32x4*)(vsrc + adv); vreg1 = *(const u32x4*)(vsrc + adv + (size_t)32 * PROJ_W); }
    *(LAS u32x4*)(lds + DA_LDS_K + kdst0) = kreg0; *(LAS u32x4*)(lds + DA_LDS_K + kdst1) = kreg1; *(LAS u32x4*)(lds + DA_LDS_V + vdst0) = vreg0; *(LAS u32x4*)(lds + DA_LDS_V + vdst1) = vreg1;
    __syncthreads();
    bool done = false;
    int t = NT - 1;
#pragma unroll 1
    for (int it = 0;; ++it, --t) {
        const int buf = it & 1;
        if (t > 0) { const size_t adv = (size_t)(t - 1) * 64 * PROJ_W; kreg0 = *(const u32x4*)(ksrc + adv); kreg1 = *(const u32x4*)(ksrc + adv + (size_t)32 * PROJ_W); vreg0 = *(const u32x4*)(vsrc + adv); vreg1 = *(const u32x4*)(vsrc + adv + (size_t)32 * PROJ_W); }
        if (t <= tmaxw && !done) {
            LAS const unsigned char* kb = lds + DA_LDS_K + buf * DA_KB + c * 8192; LAS const unsigned char* vb = lds + DA_LDS_V + buf * DA_VB;
            const float sd = slope2 * (float)(64 * t + 4 * hi - tq) - m;
            f32x16 s0, s1;
#pragma unroll
            for (int r = 0; r < 16; ++r) { s0[r] = fmaf(slope2, (float)CR(r), sd); s1[r] = fmaf(slope2, (float)(32 + CR(r)), sd); }
#pragma unroll
            for (int d0 = 0; d0 < 4; ++d0) { const int sw = ((2 * d0 + hi) ^ ((r32 >> 1) & 7)) << 4;
                const bf16x8 k0 = *(const LAS bf16x8*)(kb + r32 * 128 + sw), k1 = *(const LAS bf16x8*)(kb + (32 + r32) * 128 + sw);
                s0 = __builtin_amdgcn_mfma_f32_32x32x16_bf16(k0, qf[d0], s0, 0, 0, 0); s1 = __builtin_amdgcn_mfma_f32_32x32x16_bf16(k1, qf[d0], s1, 0, 0, 0); }
            if (t == tmaxw) { const int lim = tq - 64 * t - 4 * hi;
#pragma unroll
                for (int r = 0; r < 16; ++r) { if (CR(r) > lim) s0[r] = NEG_INF; if (32 + CR(r) > lim) s1[r] = NEG_INF; } }
            float mx = fmaxf(s0[0], s1[0]);
#pragma unroll
            for (int r = 1; r < 16; ++r) mx = fmaxf(mx, fmaxf(s0[r], s1[r]));
            mx = swap32_max(mx);
            const float dl = first ? mx : fmaxf(mx, 0.f);
            if (__any(dl != 0.f)) {
                const float alpha = first ? 1.0f : fast_exp2(-dl); m += dl; l *= alpha;
#pragma unroll
                for (int r = 0; r < 16; ++r) { s0[r] -= dl; s1[r] -= dl; }
                if (!first) {
#pragma unroll
                    for (int d = 0; d < 4; ++d)
#pragma unroll
                        for (int r = 0; r < 16; ++r) o[d][r] *= alpha; }
            }
            first = false;
            float sum = 0.f;
#pragma unroll
            for (int r = 0; r < 16; ++r) { s0[r] = fast_exp2(s0[r]); s1[r] = fast_exp2(s1[r]); sum += s0[r] + s1[r]; }
            l += sum;
            bf16x8 pk[4]; pk[0] = pack8c(s0, 0); pk[1] = pack8c(s0, 8); pk[2] = pack8c(s1, 0); pk[3] = pack8c(s1, 8);
#pragma unroll
            for (int ks = 0; ks < 4; ++ks)
#pragma unroll
                for (int db = 0; db < 4; ++db) { LAS const unsigned char* a = vb + vrd + ks * 16 * DA_VSTR + db * 64;
                    const s16x4 lo = tr_read(a), hi4 = tr_read(a + 8 * DA_VSTR);
                    const bf16x8 vf = (bf16x8){lo[0], lo[1], lo[2], lo[3], hi4[0], hi4[1], hi4[2], hi4[3]};
                    o[db] = __builtin_amdgcn_mfma_f32_32x32x16_bf16(vf, pk[ks], o[db], 0, 0, 0); }
            if (t > 0) { const float bound = qn * kpm[c * 128 + t - 1] + 0.01f - slope2 * (float)(tq - 64 * t + 1); done = __all(bound < m - DA_THR) != 0; }
        }
        if (t > 0) { const int nb = (buf ^ 1) * DA_KB, nv = (buf ^ 1) * DA_VB; *(LAS u32x4*)(lds + DA_LDS_K + nb + kdst0) = kreg0; *(LAS u32x4*)(lds + DA_LDS_K + nb + kdst1) = kreg1;
            *(LAS u32x4*)(lds + DA_LDS_V + nv + vdst0) = vreg0; *(LAS u32x4*)(lds + DA_LDS_V + nv + vdst1) = vreg1; }
        if (lane == 0) flg[buf * 8 + wid] = done ? 1 : 0;
        __syncthreads();
        if (t == 0) break;
        { const LAS int* f = flg + buf * 8; const int all = f[0] & f[1] & f[2] & f[3] & f[4] & f[5] & f[6] & f[7]; if (all) break; }
    }
    l = swap32_sum(l); const float inv = 1.0f / l;
    if (c == 0) {
#pragma unroll
        for (int d = 0; d < 4; ++d)
#pragma unroll
            for (int r = 0; r < 16; r += 2) osv[(d * 8 + (r >> 1)) * 64] = cvtpk(o[d][r] * inv, o[d][r + 1] * inv);
    }
    __syncthreads();
    if (c == 1) {
        float ssq = 0.f;
#pragma unroll
        for (int d = 0; d < 4; ++d)
#pragma unroll
            for (int r = 0; r < 16; r += 2) { const unsigned sv = osv[(d * 8 + (r >> 1)) * 64];
                const float v0 = bflo(sv) - lam * (o[d][r] * inv), v1 = bfhi(sv) - lam * (o[d][r + 1] * inv); o[d][r] = v0; o[d][r + 1] = v1; ssq += v0 * v0 + v1 * v1; }
        ssq = swap32_sum(ssq);
        const float rstd = rsqrtf(ssq * (1.0f / 128.0f) + 1e-5f) * 0.8f;
        const float* sw = C.gin(10);
        bf16_t* orow = (bf16_t*)(C.ws + WS_XN) + (size_t)(b * SEQ + tq) * DM + h * 128;
#pragma unroll
        for (int d = 0; d < 4; ++d)
#pragma unroll
            for (int p = 0; p < 2; ++p) { unsigned pk_[2][2];
#pragma unroll
                for (int q = 0; q < 2; ++q) { const int g4 = 2 * p + q, dd = 32 * d + 8 * g4 + 4 * hi; const f32x4 w = *(const f32x4*)(sw + dd);
                    pk_[q][0] = cvtpk(o[d][4 * g4] * rstd * w[0], o[d][4 * g4 + 1] * rstd * w[1]); pk_[q][1] = cvtpk(o[d][4 * g4 + 2] * rstd * w[2], o[d][4 * g4 + 3] * rstd * w[3]); }
                *(u32x4*)(orow + 32 * d + 8 * (2 * p + hi)) = pair_swap_store(pk_[0][0], pk_[0][1], pk_[1][0], pk_[1][1]); }
    }
}

constexpr int NSA_WLDS = 8192 + 4096 + 256;
struct NsaState { float m, l; f32x16 o[2]; };
struct NsaTile { bf16x8 kf[2][4]; };
struct NsaSrc { __amdgpu_buffer_rsrc_t rk, rv; unsigned kvo, vvo; int pitchB; };
__device__ __forceinline__ NsaSrc nsa_src(const bf16_t* kbase, const bf16_t* vbase, int pitch, int lane) {
    NsaSrc S; S.rk = __builtin_amdgcn_make_buffer_rsrc((void*)kbase, 0, 0x7fffffff, 0x00020000); S.rv = __builtin_amdgcn_make_buffer_rsrc((void*)vbase, 0, 0x7fffffff, 0x00020000);
    S.kvo = (unsigned)((lane & 31) * pitch + 8 * (lane >> 5)) * 2u; S.vvo = (unsigned)((lane >> 3) * pitch + (lane & 7) * 8) * 2u; S.pitchB = pitch * 2; return S;
}
__device__ __forceinline__ void nsa_issue_k(NsaTile& T, const NsaSrc& S, int row0) {
#pragma unroll
    for (int blk = 0; blk < 2; ++blk) { const int so = __builtin_amdgcn_readfirstlane((row0 + 32 * blk) * S.pitchB);
#pragma unroll
        for (int d0 = 0; d0 < 4; ++d0) T.kf[blk][d0] = __builtin_bit_cast(bf16x8, __builtin_amdgcn_raw_buffer_load_b128(S.rk, S.kvo + 32 * d0, so, 0)); }
}
template <int MODE>
__device__ __forceinline__ void nsa_step(NsaState& st, NsaTile& T, const bf16x8 (&qf)[4], const NsaSrc& S, int row0,
                                         int pos0, int pstride, int tq, float slope2, bool rowsel, LAS unsigned char* vt, LAS float* imp, int tile, float invl, int lane,
                                         bool has_next, int nrow0) {
    const int r32 = lane & 31, hi = lane >> 5;
    u32x4 vr[8];
    if (MODE != 0) {
#pragma unroll
        for (int it = 0; it < 8; ++it) vr[it] = __builtin_bit_cast(u32x4, __builtin_amdgcn_raw_buffer_load_b128(S.rv, S.vvo, __builtin_amdgcn_readfirstlane((row0 + 8 * it) * S.pitchB), 0)); }
    asm volatile("" ::: "memory");
    const float ps = (float)pstride;
    const bool unset = st.m < -1e29f; const float ref = unset ? 0.f : st.m;
    float sd = slope2 * (float)(pos0 + pstride * 4 * hi - tq) - ref;
    if (MODE == 2) sd = rowsel ? sd : NEG_INF;
    f32x16 s[2];
#pragma unroll
    for (int blk = 0; blk < 2; ++blk)
#pragma unroll
        for (int r = 0; r < 16; ++r) s[blk][r] = fmaf(slope2 * ps, (float)(32 * blk + CR(r)), sd);
#pragma unroll
    for (int blk = 0; blk < 2; ++blk)
#pragma unroll
        for (int d0 = 0; d0 < 4; ++d0) s[blk] = __builtin_amdgcn_mfma_f32_32x32x16_bf16(T.kf[blk][d0], qf[d0], s[blk], 0, 0, 0);
    if (has_next) nsa_issue_k(T, S, nrow0);
    const int tw0_ = __builtin_amdgcn_readfirstlane(tq - (r32 & 7));
    const bool needmask = (pos0 + pstride * 63 > tw0_) || (MODE == 3 && pos0 <= tw0_ + 7 - 512);
    if (needmask) {
        const int lim = tq - pos0 - pstride * 4 * hi;
#pragma unroll
        for (int blk = 0; blk < 2; ++blk)
#pragma unroll
            for (int r = 0; r < 16; ++r) { const int off = pstride * (32 * blk + CR(r)); bool ok = off <= lim;
                if (MODE == 3) ok = ok && (off > lim - 512);
                if (!ok) s[blk][r] = NEG_INF; }
    }
    if (MODE == 0 || MODE == 2 || MODE == 3) {
        float mx = fmaxf(s[0][0], s[1][0]);
#pragma unroll
        for (int r = 1; r < 16; ++r) mx = fmaxf(mx, fmaxf(s[0][r], s[1][r]));
        mx = swap32_max(mx);
        const bool none = !(mx > NEG_INF);
        const float dl = none ? 0.f : (unset ? mx : fmaxf(mx, 0.f));
        if (!(none && unset)) st.m = ref + dl;
        if (__any(dl != 0.f)) {
            const float alpha = unset ? 1.0f : fast_exp2(-dl); st.l *= alpha;
#pragma unroll
            for (int blk = 0; blk < 2; ++blk)
#pragma unroll
                for (int r = 0; r < 16; ++r) s[blk][r] -= dl;
            if (MODE != 0) {
#pragma unroll
                for (int d = 0; d < 2; ++d)
#pragma unroll
                    for (int r = 0; r < 16; ++r) st.o[d][r] *= alpha; }
        }
        float sum = 0.f;
#pragma unroll
        for (int blk = 0; blk < 2; ++blk)
#pragma unroll
            for (int r = 0; r < 16; ++r) { s[blk][r] = fast_exp2(s[blk][r]); sum += s[blk][r]; }
        st.l += sum;
    } else {
#pragma unroll
        for (int blk = 0; blk < 2; ++blk)
#pragma unroll
            for (int r = 0; r < 16; ++r) s[blk][r] = fast_exp2(s[blk][r]) * invl;
        const int tokl = r32 & 7;
#pragma unroll
        for (int blk = 0; blk < 2; ++blk)
#pragma unroll
            for (int g4 = 0; g4 < 4; ++g4) { float cy = 0.5f * s[blk][4 * g4 + 3]; float uu = s[blk][4 * g4] + s[blk][4 * g4 + 1] + s[blk][4 * g4 + 2] + cy;
                uu += dpp_f<DPP_ROR8>(uu); uu += __shfl_xor(uu, 16); cy += dpp_f<DPP_ROR8>(cy); cy += __shfl_xor(cy, 16);
                const int n = 16 * tile + 8 * blk + 2 * g4 + hi;
                if (r32 < 8) { LAS float* ip = imp + tokl * 128 + n; ip[0] = ip[0] + uu; }
                asm volatile("" ::: "memory");
                if (r32 < 8 && n + 1 < 128) { LAS float* ip = imp + tokl * 128 + n + 1; ip[0] = ip[0] + cy; }
                asm volatile("" ::: "memory"); }
    }
    if (MODE != 0) {
#pragma unroll
        for (int it = 0; it < 8; ++it) { const int key = it * 8 + (lane >> 3), ch = lane & 7; *(LAS u32x4*)(vt + (ch >> 2) * 4096 + key * 64 + (ch & 3) * 16) = vr[it]; }
        bf16x8 pk[4]; pk[0] = pack8c(s[0], 0); pk[1] = pack8c(s[0], 8); pk[2] = pack8c(s[1], 0); pk[3] = pack8c(s[1], 8);
        const int vrd = (4 * hi + ((lane & 15) >> 2)) * 64 + (16 * ((lane >> 4) & 1) + 4 * (lane & 3)) * 2;
#pragma unroll
        for (int ks = 0; ks < 4; ++ks)
#pragma unroll
            for (int db = 0; db < 2; ++db) { LAS const unsigned char* a = vt + db * 4096 + vrd + ks * 16 * 64;
                const s16x4 lo = tr_read(a), hi4 = tr_read(a + 8 * 64);
                const bf16x8 vf = (bf16x8){lo[0], lo[1], lo[2], lo[3], hi4[0], hi4[1], hi4[2], hi4[3]};
                st.o[db] = __builtin_amdgcn_mfma_f32_32x32x16_bf16(vf, pk[ks], st.o[db], 0, 0, 0); }
    }
}
__device__ __forceinline__ void nsa_reset(NsaState& st) { st.m = -1e30f; st.l = 0.f;
#pragma unroll
    for (int d = 0; d < 2; ++d)
#pragma unroll
        for (int r = 0; r < 16; ++r) st.o[d][r] = 0.f; }
__device__ __forceinline__ int next_bit128(unsigned long long lo, unsigned long long hi, int after) {
    if (after < 63) { const unsigned long long mm = lo & (~0ull << (after + 1)); if (mm) return __builtin_ctzll(mm); }
    const int a2 = after < 63 ? -1 : after - 64;
    const unsigned long long m2 = (a2 < 63) ? (hi & (~0ull << (a2 + 1))) : 0ull;
    return m2 ? 64 + __builtin_ctzll(m2) : -1;
}

__device__ __forceinline__ int prev_bit128(unsigned long long lo, unsigned long long hi, int before) {
    if (before > 64) { const unsigned long long mm = before >= 128 ? hi : (hi & ((1ull << (before - 64)) - 1ull)); if (mm) return 127 - __builtin_clzll(mm); }
    const int b2 = before > 64 ? 64 : before;
    const unsigned long long m2 = b2 >= 64 ? lo : (b2 <= 0 ? 0ull : (lo & ((1ull << b2) - 1ull)));
    return m2 ? 63 - __builtin_clzll(m2) : -1;
}
constexpr float NSA_THR = 36.0f;
__device__ __forceinline__ void nsa_unit(const Ctx& C, int b, int g, int T0) {
    const int lane = C.lane, wid = C.wave, r32 = lane & 31, hi = lane >> 5;
    const int tokl = r32 & 7, head = r32 >> 3, hq = g * 4 + head, tw0 = T0 + 8 * wid, tq = tw0 + tokl;
    const float slope2 = exp2f(-(float)(hq + 1)) * LOG2E;
    const bf16_t* P = (const bf16_t*)(C.ws + WS_PROJ) + (size_t)b * SEQ * PROJ_W;
    LAS unsigned char* vt = C.lds + wid * NSA_WLDS; LAS float* imp = (LAS float*)(vt + 8192); LAS unsigned* selm = (LAS unsigned*)(vt + 8192 + 4096);
    bf16x8 qf[4];
#pragma unroll
    for (int d0 = 0; d0 < 4; ++d0) qf[d0] = *(const bf16x8*)(P + (size_t)tq * PROJ_W + C_NQ + hq * 64 + d0 * 16 + hi * 8);
    const float* gates = (const float*)(C.ws + WS_NSAG) + (size_t)(b * SEQ + tq) * 24 + hq * 3;
    float qn;
    { float ss = 0.f;
#pragma unroll
      for (int d0 = 0; d0 < 4; ++d0) { const u32x4 w = __builtin_bit_cast(u32x4, qf[d0]);
          ss += bflo(w.x) * bflo(w.x) + bfhi(w.x) * bfhi(w.x) + bflo(w.y) * bflo(w.y) + bfhi(w.y) * bfhi(w.y) + bflo(w.z) * bflo(w.z) + bfhi(w.z) * bfhi(w.z) + bflo(w.w) * bflo(w.w) + bfhi(w.w) * bfhi(w.w); }
      qn = sqrtf(swap32_sum(ss)) * 1.001f; }
    const float kcmax = __uint_as_float(((const unsigned*)(C.ws + WS_CTL))[CW_KCMAX + b * 2 + g]);
    const float ksn_lo = ((const float*)(C.ws + WS_KSN))[(size_t)(b * 2 + g) * 128 + lane], ksn_hi = ((const float*)(C.ws + WS_KSN))[(size_t)(b * 2 + g) * 128 + 64 + lane];
    NsaState st; NsaTile T;
    LAS unsigned* accl = (LAS unsigned*)imp + lane;
    const bf16_t* kc = (const bf16_t*)(C.ws + WS_KC) + (size_t)(b * 2 + g) * 512 * 64; const bf16_t* vc = (const bf16_t*)(C.ws + WS_VC) + (size_t)(b * 2 + g) * 512 * 64;
    const int ncmp = (tw0 + 7 >= 31) ? ((tw0 + 7 - 31) >> 4) + 1 : 0, nct = (ncmp + 63) >> 6;
    nsa_reset(st);
    int ln = lane; asm volatile("" : "+v"(ln));
    int tstop = 0;
    const NsaSrc Sc = nsa_src(kc, vc, 64, ln);
    if (nct > 0) nsa_issue_k(T, Sc, 64 * (nct - 1));
    for (int t = nct - 1; t >= 0; --t) {
        bool more = t > 0;
        if (more) { const float bound = qn * kcmax + 0.01f - slope2 * (float)(tq - (16 * (64 * t - 1) + 31)); more = !(__all(bound < st.m - NSA_THR) != 0); }
        nsa_step<0>(st, T, qf, Sc, 64 * t, 16 * 64 * t + 31, 16, tq, slope2, true, vt, imp, t, 0.f, ln, more, 64 * (t - 1));
        if (!more) { tstop = t; break; }
    }
    {
        const float lt = swap32_sum(st.l); const float invl = lt > 0.f ? 1.0f / lt : 0.f;
        for (int i = lane; i < 1024; i += 64) imp[i] = 0.f;
        asm volatile("" : "+v"(ln));
        if (nct > 0) nsa_issue_k(T, Sc, 64 * tstop);
        for (int t = tstop; t < nct; ++t) nsa_step<1>(st, T, qf, Sc, 64 * t, 16 * 64 * t + 31, 16, tq, slope2, true, vt, imp, t, invl, ln, t + 1 < nct, 64 * (t + 1));
    }
    { const float gc = gates[0]; LAS float* park = (LAS float*)vt + lane;
#pragma unroll
      for (int d = 0; d < 2; ++d)
#pragma unroll
          for (int r = 0; r < 16; ++r) park[(d * 16 + r) * 64] = st.o[d][r] * gc; }
    {
        const int tokS = lane >> 3, j = lane & 7, tS = tw0 + tokS, cur = tS >> 6;
        float v[16];
#pragma unroll
        for (int i = 0; i < 16; ++i) { const int n = 16 * j + i; const float val = imp[tokS * 128 + n]; const bool causal = n <= cur, forced = (n == 0) || (n == cur) || (n == cur - 1);
            v[i] = causal ? val + (forced ? 1e4f : 0.f) : NEG_INF; }
        unsigned mk0 = 0u, mk1 = 0u, mk2 = 0u, mk3 = 0u;
#pragma unroll 1
        for (int it = 0; it < 16; ++it) {
            float bv = v[0]; int bi = 0;
#pragma unroll
            for (int i = 1; i < 16; ++i) if (v[i] > bv) { bv = v[i]; bi = i; }
            int bn = 16 * j + bi;
#define SEL_STEP(CTRL) { const float ov = dpp_f<CTRL>(bv); const int on = dpp_i<CTRL>(bn); if (ov > bv || (ov == bv && on < bn)) { bv = ov; bn = on; } }
            SEL_STEP(DPP_XOR1) SEL_STEP(DPP_XOR2) SEL_STEP(DPP_HMIRROR)
#undef SEL_STEP
            if (bv > NEG_INF) { const unsigned bit = 1u << (bn & 31); const int w = bn >> 5;
                mk0 |= (w == 0) ? bit : 0u; mk1 |= (w == 1) ? bit : 0u; mk2 |= (w == 2) ? bit : 0u; mk3 |= (w == 3) ? bit : 0u;
#pragma unroll
                for (int i = 0; i < 16; ++i) if (16 * j + i == bn) v[i] = NEG_INF; }
        }
        if (j == 0) { selm[tokS * 4 + 0] = mk0; selm[tokS * 4 + 1] = mk1; selm[tokS * 4 + 2] = mk2; selm[tokS * 4 + 3] = mk3; }
        unsigned U[4] = {mk0, mk1, mk2, mk3};
#pragma unroll
        for (int w = 0; w < 4; ++w) { U[w] |= __shfl_xor(U[w], 8); U[w] |= __shfl_xor(U[w], 16); U[w] |= __shfl_xor(U[w], 32); U[w] = __builtin_amdgcn_readfirstlane(U[w]); }
        const unsigned long long ulo = (unsigned long long)U[0] | ((unsigned long long)U[1] << 32), uhi = (unsigned long long)U[2] | ((unsigned long long)U[3] << 32);
        { LAS const float* park = (LAS const float*)vt + lane;
#pragma unroll
        for (int d = 0; d < 2; ++d)
#pragma unroll
            for (int r = 0; r < 16; r += 2) accl[(d * 8 + (r >> 1)) * 64] = pk2(park[(d * 16 + r) * 64], park[(d * 16 + r + 1) * 64]); }
        nsa_reset(st);
        const bf16_t* ks = P + C_SK + g * 64; const bf16_t* vs = P + C_SV + g * 64;
        const unsigned m0 = selm[tokl * 4 + 0], m1 = selm[tokl * 4 + 1], m2 = selm[tokl * 4 + 2], m3 = selm[tokl * 4 + 3];
        int n = prev_bit128(ulo, uhi, 128);
        asm volatile("" : "+v"(ln));
        const NsaSrc Ss = nsa_src(ks, vs, PROJ_W, ln);
        if (n >= 0) nsa_issue_k(T, Ss, 64 * n);
        while (n >= 0) {
            int nx = prev_bit128(ulo, uhi, n);
            while (nx >= 0) {
                const unsigned mx_ = (nx < 32) ? m0 : (nx < 64) ? m1 : (nx < 96) ? m2 : m3; const bool rs = ((mx_ >> (nx & 31)) & 1u) != 0u;
                const float kn = __uint_as_float(__builtin_amdgcn_readlane(__float_as_uint(nx < 64 ? ksn_lo : ksn_hi), nx & 63));
                const float bound = qn * kn + 0.01f - slope2 * (float)(tq - (64 * nx + 63));
                if (!(__all(!rs || bound < st.m - NSA_THR) != 0)) break;
                nx = prev_bit128(ulo, uhi, nx);
            }
            const unsigned mw = (n < 32) ? m0 : (n < 64) ? m1 : (n < 96) ? m2 : m3;
            nsa_step<2>(st, T, qf, Ss, 64 * n, 64 * n, 1, tq, slope2, ((mw >> (n & 31)) & 1u) != 0u, vt, imp, 0, 0.f, ln, nx >= 0, 64 * nx);
            n = nx;
        }
        { const float lt = swap32_sum(st.l); const float sc = gates[1] / lt;
#pragma unroll
            for (int d = 0; d < 2; ++d)
#pragma unroll
                for (int r = 0; r < 16; r += 2) { const unsigned pv = accl[(d * 8 + (r >> 1)) * 64]; accl[(d * 8 + (r >> 1)) * 64] = pk2(bflo(pv) + st.o[d][r] * sc, bfhi(pv) + st.o[d][r + 1] * sc); } }
    }
    {
        nsa_reset(st);
        const bf16_t* kw = P + C_WK + g * 64; const bf16_t* vw = P + C_WV + g * 64;
        const int lo = tw0 - 511, nlo = lo > 0 ? (lo >> 6) : 0, nhi = (tw0 + 7) >> 6;
        asm volatile("" : "+v"(ln));
        const NsaSrc Sw = nsa_src(kw, vw, PROJ_W, ln);
        nsa_issue_k(T, Sw, 64 * nhi);
        for (int n = nhi; n >= nlo; --n) nsa_step<3>(st, T, qf, Sw, 64 * n, 64 * n, 1, tq, slope2, true, vt, imp, 0, 0.f, ln, n > nlo, 64 * (n - 1));
        const float lt = swap32_sum(st.l); const float sc = gates[2] / lt;
        bf16_t* orow = (bf16_t*)(C.ws + WS_OB) + (size_t)(b * SEQ + tq) * 512 + hq * 64;
#pragma unroll
        for (int d = 0; d < 2; ++d)
#pragma unroll
            for (int p = 0; p < 2; ++p) { unsigned pk_[2][2];
#pragma unroll
                for (int q = 0; q < 2; ++q) { const int g4 = 2 * p + q; const unsigned p0 = accl[(d * 8 + 2 * g4) * 64], p1 = accl[(d * 8 + 2 * g4 + 1) * 64];
                    pk_[q][0] = pk2(bflo(p0) + st.o[d][4 * g4] * sc, bfhi(p0) + st.o[d][4 * g4 + 1] * sc); pk_[q][1] = pk2(bflo(p1) + st.o[d][4 * g4 + 2] * sc, bfhi(p1) + st.o[d][4 * g4 + 3] * sc); }
                *(u32x4*)(orow + 32 * d + 8 * (2 * p + hi)) = pair_swap_store(pk_[0][0], pk_[0][1], pk_[1][0], pk_[1][1]); }
    }
}

constexpr int CONV_PER_UNIT = 24, N_CONV_UNITS = 3 * 64 * 128 / CONV_PER_UNIT;
__device__ __forceinline__ void conv_unit(const Ctx& C, int cu) {
    LAS float* scr = (LAS float*)(C.lds + C.wave * 16384);
    unsigned char* ws = C.ws;
#pragma unroll 1
    for (int j = 0; j < CONV_PER_UNIT / NWAVES; ++j) {
        int r = cu * CONV_PER_UNIT + j * NWAVES + C.wave;
        if (r < 64 * 128) { const int e = r >> 7; transpose_item(C.gin(23) + (size_t)e * 1024 * 256, 1024, 256, (bf16_t*)(ws + WS_WGU) + (size_t)e * 512 * 1024, 2, scr, r & 127, C.lane); continue; } r -= 64 * 128;
        if (r < 64 * 128) { const int e = r >> 7; transpose_item(C.gin(24) + (size_t)e * 1024 * 256, 1024, 256, (bf16_t*)(ws + WS_WGU) + (size_t)e * 512 * 1024, 3, scr, r & 127, C.lane); continue; } r -= 64 * 128;
        { const int e = r >> 7; transpose_item(C.gin(25) + (size_t)e * 256 * 1024, 256, 1024, (bf16_t*)(ws + WS_WDN) + (size_t)e * 1024 * 256, 0, scr, r & 127, C.lane); }
    }
}

__device__ __forceinline__ void attention_phase(const Ctx& C) {
    float lam;
    { const float a = wave_sum(C.gin(6)[C.lane] * C.gin(7)[C.lane]), bq = wave_sum(C.gin(8)[C.lane] * C.gin(9)[C.lane]); lam = __expf(a) - __expf(bq) + 0.2f; }
    unsigned* gq = (unsigned*)(C.ws + WS_CTL) + 64;
    LAS int* qw = (LAS int*)(C.lds + ATT_LDS_Q);
    if (C.tid == 0) qw[0] = (int)__hip_atomic_fetch_add(gq, 1u, __ATOMIC_RELAXED, __HIP_MEMORY_SCOPE_AGENT);
    __syncthreads();
#pragma unroll 1
    for (int n = 0;; ++n) {
        const int uq = qw[n & 1]; if (uq >= 2048 + N_CONV_UNITS) break;
        if (C.tid == 0) qw[(n + 1) & 1] = (int)__hip_atomic_fetch_add(gq, 1u, __ATOMIC_RELAXED, __HIP_MEMORY_SCOPE_AGENT);
        if (uq < 3 * N_CONV_UNITS && (uq % 3) == 2) { conv_unit(C, uq / 3); }
        else { const int u = uq < 3 * N_CONV_UNITS ? uq - uq / 3 : uq - N_CONV_UNITS;
            da_unit(C, u & 3, 7 - ((u >> 2) & 7), 63 - (u >> 5), lam);
        }
        __syncthreads();
    }
    __syncthreads();
    if (C.tid == 0) qw[0] = (int)__hip_atomic_fetch_add(gq + 1, 1u, __ATOMIC_RELAXED, __HIP_MEMORY_SCOPE_AGENT);
    __syncthreads();
#pragma unroll 1
    for (int n = 0;; ++n) {
        const int u = qw[n & 1]; if (u >= 1024) break;
        if (C.tid == 0) qw[(n + 1) & 1] = (int)__hip_atomic_fetch_add(gq + 1, 1u, __ATOMIC_RELAXED, __HIP_MEMORY_SCOPE_AGENT);
        const int bg = ((u & 3) << 1) | (u < 512 ? 1 : 0), tile = 127 - ((u & 511) >> 2);
        nsa_unit(C, bg >> 1, bg & 1, tile * 64);
        __syncthreads();
    }
    __syncthreads();
}

__device__ __forceinline__ void router_bias(const Ctx& C) {
    const float* mod = (const float*)(C.ws + WS_MOD); LAS float* red = (LAS float*)C.lds;
    for (int i = C.bid; i < 256; i += C.G) { const int b = i >> 6, e = i & 63;
        const float* sh = mod + b * 6144 + 3072; const float* W = C.gin(21) + e;
        float a = sh[C.tid] * W[(size_t)C.tid * 64] + sh[C.tid + 512] * W[(size_t)(C.tid + 512) * 64];
        a = wave_sum(a);
        __syncthreads();
        if (C.lane == 0) red[C.wave] = a;
        __syncthreads();
        if (C.tid == 0) ((float*)(C.ws + WS_RBIAS))[i] = ((red[0] + red[1]) + (red[2] + red[3])) + ((red[4] + red[5]) + (red[6] + red[7]));
    }
}
constexpr int P7_LOG = 0;
constexpr int P7_ASG = 128 * 65 * 4;
constexpr int P7_LCNT = P7_ASG + 128 * 8 * 12;
constexpr int P7_PSTR = 68;
constexpr int P7_PART = P7_LCNT + 512;
constexpr int P7_RSTD = P7_PART + 8 * 32 * P7_PSTR * 4;
constexpr int P7_G = P7_RSTD + 512;
constexpr int P7_SH = P7_G + 4096;
constexpr int P7_BIAS = P7_SH + 4096;
static_assert(P7_BIAS + 256 <= 131072, "P7 LDS map");
__device__ __forceinline__ void route_phase(const Ctx& C) {
    const int lane = C.lane, wid = C.wave, fr = lane & 15, kq = lane >> 4;
    const float* mod = (const float*)(C.ws + WS_MOD);
    bf16_t* XN = (bf16_t*)(C.ws + WS_XN);
    static_assert(WS_RLO == WS_RHI + 131072, "hi and lo router weights are one 256 KiB buffer");
    const __amdgpu_buffer_rsrc_t rr = __builtin_amdgcn_make_buffer_rsrc((void*)(C.ws + WS_RHI), 0, 262144, 0x00020000);
    LAS float* logit = (LAS float*)(C.lds + P7_LOG) + wid * 16 * 65;
    LAS int* asg = (LAS int*)(C.lds + P7_ASG); LAS int* lcnt = (LAS int*)(C.lds + P7_LCNT); LAS int* lbase = lcnt + 64;
    LAS float* part = (LAS float*)(C.lds + P7_PART); LAS float* rstds = (LAS float*)(C.lds + P7_RSTD);
    LAS float* gv = (LAS float*)(C.lds + P7_G); LAS float* shv = (LAS float*)(C.lds + P7_SH); LAS float* biasp = (LAS float*)(C.lds + P7_BIAS);
    unsigned* gcnt = (unsigned*)(C.ws + WS_CTL);
    int* rowslot = (int*)(C.ws + WS_RSLOT); int* tokrow = (int*)(C.ws + WS_RW); float* tokw = (float*)(C.ws + WS_RW + 2 * MiB);
    for (int chunk = C.bid; chunk < NTOK / 128; chunk += C.G) {
        const int bb = (chunk * 128) / SEQ;
        if (C.tid < 64) lcnt[C.tid] = 0;
        for (int i = C.tid; i < 1024; i += NTHREADS) { gv[i] = C.gin(20)[i] * (mod[bb * 6144 + 4096 + i] + 1.0f); shv[i] = mod[bb * 6144 + 3072 + i]; }
        if (C.tid < 128) { const float* sp = (const float*)(C.ws + WS_LO) + chunk * 128 + C.tid; float a = 0.f;
#pragma unroll
            for (int p = 0; p < 16; ++p) a += sp[(size_t)p * NTOK];
            rstds[C.tid] = rsqrtf(a * (1.f / DM) + 1e-6f); }
        else if (C.tid < 192) biasp[C.tid - 128] = ((const float*)(C.ws + WS_RBIAS))[bb * 64 + C.tid - 128];
        __syncthreads();
        const int kb = 128 * wid + 8 * kq;
        const unsigned boff = (unsigned)(wid * 32768 + lane * 16);
        f32x4 v[2][4][2];
#pragma unroll
        for (int t = 0; t < 2; ++t) { const float* xr = C.out + (size_t)(chunk * 128 + 16 * t + fr) * DM + kb;
#pragma unroll
            for (int ks = 0; ks < 4; ++ks) { v[t][ks][0] = *(const f32x4*)(xr + 32 * ks); v[t][ks][1] = *(const f32x4*)(xr + 32 * ks + 4); } }
        bf16x8 b_h[4], b_l[4];
#pragma unroll
        for (int n = 0; n < 4; ++n) { b_h[n] = __builtin_bit_cast(bf16x8, __builtin_amdgcn_raw_buffer_load_b128(rr, boff, n * 2048, 0)); b_l[n] = __builtin_bit_cast(bf16x8, __builtin_amdgcn_raw_buffer_load_b128(rr, boff, n * 2048 + 1024, 0)); }
        __builtin_amdgcn_sched_barrier(0);
#pragma unroll 1
        for (int it = 0; it < 4; ++it) {
            const int r0 = chunk * 128 + it * 32, rn = it < 3 ? r0 + 32 : r0;
            f32x4 acc[2][4];
#pragma unroll
            for (int t = 0; t < 2; ++t)
#pragma unroll
                for (int n = 0; n < 4; ++n) acc[t][n] = (f32x4){0.f, 0.f, 0.f, 0.f};
            const float rs[2] = {rstds[it * 32 + fr], rstds[it * 32 + 16 + fr]};
#pragma unroll
            for (int ks = 0; ks < 4; ++ks) {
                const f32x4 g0 = *(const LAS f32x4*)(gv + kb + 32 * ks), g1 = *(const LAS f32x4*)(gv + kb + 32 * ks + 4);
                const f32x4 s0 = *(const LAS f32x4*)(shv + kb + 32 * ks), s1 = *(const LAS f32x4*)(shv + kb + 32 * ks + 4);
                bf16x8 a_h[2], a_l[2];
#pragma unroll
                for (int t = 0; t < 2; ++t) { const f32x4 u0 = v[t][ks][0] * g0, u1 = v[t][ks][1] * g1; u32x4 h, l;
                    { const float* xr = C.out + (size_t)(rn + 16 * t + fr) * DM + kb + 32 * ks; v[t][ks][0] = *(const f32x4*)xr; v[t][ks][1] = *(const f32x4*)(xr + 4); }
                    h.x = pk2(u0.x, u0.y); h.y = pk2(u0.z, u0.w); h.z = pk2(u1.x, u1.y); h.w = pk2(u1.z, u1.w);
                    l.x = pk2(u0.x - bflo(h.x), u0.y - bfhi(h.x)); l.y = pk2(u0.z - bflo(h.y), u0.w - bfhi(h.y)); l.z = pk2(u1.x - bflo(h.z), u1.y - bfhi(h.z)); l.w = pk2(u1.z - bflo(h.w), u1.w - bfhi(h.w));
                    a_h[t] = __builtin_bit_cast(bf16x8, h); a_l[t] = __builtin_bit_cast(bf16x8, l);
                    const f32x4 y0 = u0 * rs[t] + s0, y1 = u1 * rs[t] + s1;
                    u32x4 o; o.x = pk2(y0.x, y0.y); o.y = pk2(y0.z, y0.w); o.z = pk2(y1.x, y1.y); o.w = pk2(y1.z, y1.w);
                    *(u32x4*)(XN + (size_t)(r0 + 16 * t + fr) * DM + kb + 32 * ks) = o; }
#pragma unroll
                for (int n = 0; n < 4; ++n) {
#pragma unroll
                    for (int t = 0; t < 2; ++t) {
                        acc[t][n] = __builtin_amdgcn_mfma_f32_16x16x32_bf16(a_h[t], b_h[n], acc[t][n], 0, 0, 0);
                        acc[t][n] = __builtin_amdgcn_mfma_f32_16x16x32_bf16(a_l[t], b_h[n], acc[t][n], 0, 0, 0);
                        acc[t][n] = __builtin_amdgcn_mfma_f32_16x16x32_bf16(a_h[t], b_l[n], acc[t][n], 0, 0, 0); }
                    b_h[n] = __builtin_bit_cast(bf16x8, __builtin_amdgcn_raw_buffer_load_b128(rr, boff, ((ks + 1) & 3) * 8192 + n * 2048, 0)); b_l[n] = __builtin_bit_cast(bf16x8, __builtin_amdgcn_raw_buffer_load_b128(rr, boff, ((ks + 1) & 3) * 8192 + n * 2048 + 1024, 0)); }
                __builtin_amdgcn_sched_barrier(0);
            }
#pragma unroll
            for (int t = 0; t < 2; ++t)
#pragma unroll
                for (int n = 0; n < 4; ++n)
#pragma unroll
                    for (int i = 0; i < 4; ++i) part[(wid * 32 + 16 * t + 4 * kq + i) * P7_PSTR + 16 * n + fr] = acc[t][n][i];
            asm volatile("s_waitcnt lgkmcnt(0)" ::: "memory"); __builtin_amdgcn_s_barrier(); asm volatile("" ::: "memory");
            {
                const int row = C.tid >> 4, e4 = (C.tid & 15) * 4; f32x4 sum = (f32x4){0.f, 0.f, 0.f, 0.f};
#pragma unroll
                for (int w = 0; w < 8; ++w) sum += *(const LAS f32x4*)(part + (w * 32 + row) * P7_PSTR + e4);
                const float rstd = rstds[it * 32 + row];
                LAS float* lo = (LAS float*)(C.lds + P7_LOG) + (it * 32 + row) * 65 + e4;
#pragma unroll
                for (int j = 0; j < 4; ++j) lo[j] = rstd * sum[j] + biasp[e4 + j];
            }
            asm volatile("s_waitcnt lgkmcnt(0)" ::: "memory"); __builtin_amdgcn_s_barrier(); asm volatile("" ::: "memory");
        }
        {
            const int rrow = lane >> 2, q = lane & 3; LAS const float* L = logit + rrow * 65 + 16 * q; const float* rb = C.gin(22) + 16 * q;
            float sc[16], bs[16];
#pragma unroll
            for (int i = 0; i < 16; ++i) { sc[i] = sigmoidf_(L[i]); bs[i] = sc[i] + rb[i]; }
            float gsc[2];
#pragma unroll
            for (int gi = 0; gi < 2; ++gi) { float t1 = NEG_INF, t2 = NEG_INF;
#pragma unroll
                for (int i = 0; i < 8; ++i) { const float v = bs[8 * gi + i]; if (v > t1) { t2 = t1; t1 = v; } else if (v > t2) t2 = v; }
                gsc[gi] = t1 + t2; }
            bool gsel[2] = {false, false};
#pragma unroll
            for (int it = 0; it < 4; ++it) {
                float bv = NEG_INF; int bi = 1 << 20;
                if (!gsel[0]) { bv = gsc[0]; bi = 2 * q; }
                if (!gsel[1] && gsc[1] > bv) { bv = gsc[1]; bi = 2 * q + 1; }
#pragma unroll
                for (int st_ = 0; st_ < 2; ++st_) { const float ov = st_ ? dpp_f<DPP_XOR2>(bv) : dpp_f<DPP_XOR1>(bv); const int oi = st_ ? dpp_i<DPP_XOR2>(bi) : dpp_i<DPP_XOR1>(bi); if (ov > bv || (ov == bv && oi < bi)) { bv = ov; bi = oi; } }
                if (bi == 2 * q) gsel[0] = true; if (bi == 2 * q + 1) gsel[1] = true;
            }
#pragma unroll
            for (int i = 0; i < 16; ++i) if (!gsel[i >> 3]) bs[i] = NEG_INF;
            int te[8]; float tw[8]; float wsum = 0.f;
#pragma unroll
            for (int k = 0; k < 8; ++k) {
                float bv = bs[0]; int bi = 0;
#pragma unroll
                for (int i = 1; i < 16; ++i) if (bs[i] > bv) { bv = bs[i]; bi = i; }
                float bw = sc[0];
#pragma unroll
                for (int i = 1; i < 16; ++i) bw = (bi == i) ? sc[i] : bw;
                int be = 16 * q + bi;
#pragma unroll
                for (int st_ = 0; st_ < 2; ++st_) { const float ov = st_ ? dpp_f<DPP_XOR2>(bv) : dpp_f<DPP_XOR1>(bv); const int oe = st_ ? dpp_i<DPP_XOR2>(be) : dpp_i<DPP_XOR1>(be); const float ow = st_ ? dpp_f<DPP_XOR2>(bw) : dpp_f<DPP_XOR1>(bw); if (ov > bv || (ov == bv && oe < be)) { bv = ov; be = oe; bw = ow; } }
#pragma unroll
                for (int i = 0; i < 16; ++i) if (16 * q + i == be) bs[i] = NEG_INF;
                te[k] = be; tw[k] = bw; wsum += bw;
            }
            const float wn = 2.5f / wsum; const int lrow = wid * 16 + rrow;
#pragma unroll
            for (int k = 0; k < 8; ++k) if ((k >> 1) == q) { const int posl = atomicAdd((int*)(lcnt + te[k]), 1); LAS int* a = asg + (lrow * 8 + k) * 3; a[0] = te[k]; a[1] = posl; a[2] = __float_as_int(tw[k] * wn); }
        }
        __syncthreads();
        if (C.tid < 64) lbase[C.tid] = (int)atomicAdd(gcnt + C.tid, (unsigned)lcnt[C.tid]);
        __syncthreads();
        for (int i = C.tid; i < 1024; i += NTHREADS) { LAS int* a = asg + i * 3; const int e = a[0]; const size_t li = (size_t)e * CAP + lbase[e] + a[1];
            const int slot = (chunk * 128 + (i >> 3)) * 8 + (i & 7);
            rowslot[li] = slot; tokrow[slot] = e | ((lbase[e] + a[1]) << 8); tokw[slot] = __int_as_float(a[2]); }
        __syncthreads();
    }
}

constexpr int MISC_OFF = 131072 + 1024;
constexpr int SCHED_OFF = 131072;
constexpr int TEXP_OFF = 131072 + 2048;
__device__ __forceinline__ int build_sched(const Ctx& C) {
    LAS int* tstart = (LAS int*)(C.lds + SCHED_OFF); LAS int* astart = tstart + 66; LAS unsigned char* texp = C.lds + TEXP_OFF;
    __syncthreads();
    if (C.wave == 0) { const unsigned* gcnt = (const unsigned*)(C.ws + WS_CTL);
        const int c = (int)__hip_atomic_load(gcnt + C.lane, __ATOMIC_RELAXED, __HIP_MEMORY_SCOPE_AGENT); const int tl = (c + 255) >> 8;
        int as = c, ts = tl;
#pragma unroll
        for (int o = 1; o < 64; o <<= 1) { const int ua = __shfl_up(as, o), ut = __shfl_up(ts, o); if (C.lane >= o) { as += ua; ts += ut; } }
        astart[C.lane] = as - c; tstart[C.lane] = ts - tl;
        if (C.lane == 63) { tstart[64] = ts; astart[64] = NTOK * 8; tstart[65] = ts + NTOK / 256; astart[65] = NTOK * 8 + NTOK; } }
    __syncthreads();
    if (C.tid < 65) for (int mt = tstart[C.tid]; mt < tstart[C.tid + 1]; ++mt) texp[mt] = (unsigned char)C.tid;
    __syncthreads();
    return tstart[65];
}

__device__ __forceinline__ f32x4 bf4lo(const u32x4& y) { return (f32x4){bflo(y.x), bfhi(y.x), bflo(y.y), bfhi(y.y)}; }
__device__ __forceinline__ f32x4 bf4hi(const u32x4& y) { return (f32x4){bflo(y.z), bfhi(y.z), bflo(y.w), bfhi(y.w)}; }
template <bool FINAL>
__device__ __forceinline__ void combine_round(const Ctx& C, int j) {
    const int gw = C.bid * NWAVES + C.wave, NGW = C.G * NWAVES; const float* mod = (const float*)(C.ws + WS_MOD);
    const bf16_t* YS = (const bf16_t*)(C.ws + WS_YS); const int* tokrow = (const int*)(C.ws + WS_RW); const float* tokw = (const float*)(C.ws + WS_RW + 2 * MiB);
    const LAS int* astart = (const LAS int*)(C.lds + SCHED_OFF) + 66;
    static_assert(NSPLIT == 2 && YW == 512, "two column rounds of 512, 8 columns per lane");
    if (FINAL) asm volatile("s_waitcnt vmcnt(0)" ::: "memory");
    const int c = 8 * C.lane;
    u32x4 ra, rb; f32x4 wa, wb;
    if (gw < NTOK) { ra = *(const u32x4*)(tokrow + (size_t)gw * 8); rb = *(const u32x4*)(tokrow + (size_t)gw * 8 + 4); wa = *(const f32x4*)(tokw + (size_t)gw * 8); wb = *(const f32x4*)(tokw + (size_t)gw * 8 + 4); }
    for (int m = gw; m < NTOK; m += NGW) {
        const int b = m / SEQ;
        const unsigned rr[8] = {ra.x, ra.y, ra.z, ra.w, rb.x, rb.y, rb.z, rb.w}; const float ww[8] = {wa[0], wa[1], wa[2], wa[3], wb[0], wb[1], wb[2], wb[3]};
        u32x4 y[9];
#pragma unroll
        for (int k = 0; k < 8; ++k) { const int row = astart[rr[k] & 255u] + (int)(rr[k] >> 8); y[k] = __builtin_nontemporal_load((const u32x4*)(YS + (size_t)row * YW + c)); }
        y[8] = __builtin_nontemporal_load((const u32x4*)(YS + ((size_t)NTOK * 8 + m) * YW + c));
        const int mn = m + NGW;
        if (mn < NTOK) { ra = *(const u32x4*)(tokrow + (size_t)mn * 8); rb = *(const u32x4*)(tokrow + (size_t)mn * 8 + 4); wa = *(const f32x4*)(tokw + (size_t)mn * 8); wb = *(const f32x4*)(tokw + (size_t)mn * 8 + 4); }
        float* xr = C.out + (size_t)m * DM;
        f32x4 a0 = bf4lo(y[8]), a1 = bf4hi(y[8]);
#pragma unroll
        for (int k = 0; k < 8; ++k) { a0 += bf4lo(y[k]) * ww[k]; a1 += bf4hi(y[k]) * ww[k]; }
        const float* g2 = mod + b * 6144 + 5120 + j * YW + c;
        const f32x4 q0 = *(const f32x4*)(xr + j * YW + c) + *(const f32x4*)g2 * a0, q1 = *(const f32x4*)(xr + j * YW + c + 4) + *(const f32x4*)(g2 + 4) * a1;
        if (!FINAL) { *(f32x4*)(xr + j * YW + c) = q0; *(f32x4*)(xr + j * YW + c + 4) = q1; }
        else {
            const f32x4 p0 = *(const f32x4*)(xr + c), p1 = *(const f32x4*)(xr + c + 4);
            float ss = (p0.x * p0.x + p0.y * p0.y) + (p0.z * p0.z + p0.w * p0.w) + (p1.x * p1.x + p1.y * p1.y) + (p1.z * p1.z + p1.w * p1.w)
                     + (q0.x * q0.x + q0.y * q0.y) + (q0.z * q0.z + q0.w * q0.w) + (q1.x * q1.x + q1.y * q1.y) + (q1.z * q1.z + q1.w * q1.w);
            const float rstd = rsqrtf(wave_sum(ss) * (1.f / DM) + 1e-6f);
            const float* fw = C.gin(29);
            *(f32x4*)(xr + c) = p0 * rstd * *(const f32x4*)(fw + c); *(f32x4*)(xr + c + 4) = p1 * rstd * *(const f32x4*)(fw + c + 4);
            *(f32x4*)(xr + YW + c) = q0 * rstd * *(const f32x4*)(fw + YW + c); *(f32x4*)(xr + YW + c + 4) = q1 * rstd * *(const f32x4*)(fw + YW + c + 4);
        }
    }
}

__global__ void __launch_bounds__(NTHREADS, 2) mega_fwd(const float* i0, const float* i1, const float* i2, const float* i3, const float* i4, const float* i5, const float* i6, const float* i7, const float* i8, const float* i9, const float* i10, const float* i11, const float* i12, const float* i13, const float* i14, const float* i15, const float* i16, const float* i17, const float* i18, const float* i19, const float* i20, const float* i21, const float* i22, const float* i23, const float* i24, const float* i25, const float* i26, const float* i27, const float* i28, const float* i29, float* out_arg, unsigned char* ws_arg) {
    extern __shared__ __attribute__((aligned(16))) unsigned char lds_raw[];
    Ctx C; C.lds = (LAS unsigned char*)lds_raw; C.tid = threadIdx.x; C.lane = C.tid & 63; C.wave = __builtin_amdgcn_readfirstlane(C.tid >> 6); C.G = gridDim.x; C.bid = blockIdx.x;
    C.in[0] = i0; C.in[1] = i1; C.in[2] = i2; C.in[3] = i3; C.in[4] = i4; C.in[5] = i5; C.in[6] = i6; C.in[7] = i7; C.in[8] = i8; C.in[9] = i9; C.in[10] = i10; C.in[11] = i11; C.in[12] = i12; C.in[13] = i13; C.in[14] = i14; C.in[15] = i15; C.in[16] = i16; C.in[17] = i17; C.in[18] = i18; C.in[19] = i19; C.in[20] = i20; C.in[21] = i21; C.in[22] = i22; C.in[23] = i23; C.in[24] = i24; C.in[25] = i25; C.in[26] = i26; C.in[27] = i27; C.in[28] = i28; C.in[29] = i29;
    C.out = out_arg; C.ws = ws_arg;
    unsigned char* ws = C.ws;
    LAS unsigned char* lds = C.lds;
    if (C.tid < 4) ((LAS unsigned*)(lds + MISC_OFF))[C.tid] = 0u;
    __syncthreads();
    const XcdBarrier xbar = xcd_barrier_post((unsigned*)(ws + WS_BAR), (volatile LAS unsigned*)(lds + MISC_OFF));
#define GSYNC() xcd_barrier(xbar)

#define LAUNDER() do { size_t z_ = 0; asm volatile("" : "+s"(z_)); C.ws = ws_arg + z_; C.out = out_arg + z_; ws = C.ws; int t_ = threadIdx.x; asm volatile("" : "+v"(t_)); C.tid = t_; C.lane = t_ & 63; C.wave = __builtin_amdgcn_readfirstlane(t_ >> 6); } while (0)
    LAUNDER(); p0_prologue(C);
    GSYNC();
    LAUNDER(); modulate_rows(C, C.gin(0), C.gin(4), 0, 1024, (bf16_t*)(ws + WS_XN));
    router_bias(C);
    GSYNC();
    {
        LAUNDER();
        pg8::Gemm g{(const bf16_t*)(ws + WS_XN), (const bf16_t*)(ws + WS_WIN), DM}; pg8::DenseSched S; S.init(NTOK, NIN, C.G, C.bid);
        EpiProj E{(bf16_t*)(ws + WS_PROJ), (bf16_t*)C.out, (float*)(ws + WS_NSAG)};
        pg8::gemm_phase<EpiProj, pg8::DenseSched, false>(lds, g, S, E);
    }
    GSYNC();
    LAUNDER(); compress_phase(C); knorm_phase(C);
    GSYNC();
    LAUNDER(); attention_phase(C);
    GSYNC();
    {
        LAUNDER();
        pg8::DenseSched S; S.init(NTOK, DM, C.G, C.bid);
        pg8::Gemm ga{(const bf16_t*)(ws + WS_XN), (const bf16_t*)(ws + WS_WDA), 1024};
        EpiGate<false> Ea{(bf16_t*)(ws + WS_MERGED), (const bf16_t*)C.out, 0};
        pg8::gemm_phase<EpiGate<false>, pg8::DenseSched, false>(lds, ga, S, Ea);
        LAUNDER();
        pg8::Gemm gb{(const bf16_t*)(ws + WS_OB), (const bf16_t*)(ws + WS_WNSA), 512};
        EpiGate<true> Eb{(bf16_t*)(ws + WS_MERGED), (const bf16_t*)C.out, 1024};
        pg8::gemm_phase<EpiGate<true>, pg8::DenseSched, false>(lds, gb, S, Eb);
    }
    GSYNC();
    {
        LAUNDER();
        pg8::DenseSched S; S.init(NTOK, DM, C.G, C.bid);
        pg8::Gemm g{(const bf16_t*)(ws + WS_MERGED), (const bf16_t*)(ws + WS_WO), 1024};
        EpiResid E{C.gin(0), (const float*)(ws + WS_MOD), C.out, (float*)(ws + WS_LO)};
        pg8::gemm_phase<EpiResid, pg8::DenseSched, false>(lds, g, S, E);
    }
    GSYNC();
    LAUNDER(); route_phase(C);
    GSYNC();
    LAUNDER();
    const int ntile = build_sched(C);
    const LAS int* tstart = (const LAS int*)(lds + SCHED_OFF); const LAS int* astart = tstart + 66; const LAS unsigned char* texp = lds + TEXP_OFF;
    {
        LAUNDER();
        pg8::Gemm g{(const bf16_t*)(ws + WS_XN), (const bf16_t*)(ws + WS_WGU), 1024};
        pg8::ExpertSched S{tstart, astart, texp, (const int*)(ws + WS_RSLOT), ntile, 2, 2, 0, C.G, C.bid};
        EpiAct E{(bf16_t*)(ws + WS_ACT), astart};
        pg8::gemm_phase<EpiAct, pg8::ExpertSched, true>(lds, g, S, E);
    }
    GSYNC();
#pragma unroll 1
    for (int j = 0; j < NSPLIT; ++j) {
        {
            LAUNDER();
            pg8::Gemm g{(const bf16_t*)(ws + WS_ACT), (const bf16_t*)(ws + WS_WDN), 256};
            pg8::ExpertSched S{tstart, astart, texp, (const int*)(ws + WS_RSLOT), ntile, YW / 256, 4, j * (YW / 256), C.G, C.bid};
            EpiDown E{(bf16_t*)(ws + WS_YS), astart};
            pg8::gemm_phase<EpiDown, pg8::ExpertSched, false, false>(lds, g, S, E);
        }
        GSYNC();
        LAUNDER();
        if (j + 1 < NSPLIT) { combine_round<false>(C, j); GSYNC(); } else combine_round<true>(C, j);
    }
}

extern "C" void kernel_launch(void* const* d_in, const int* in_sizes, int n_in,
                              void* d_out, int out_size, void* d_ws, size_t ws_size,
                              hipStream_t stream) {
    static int grid_blocks = 0;
    if (!grid_blocks) {
        int dev = 0, cus = 0, per_cu = 0;
        (void)hipGetDevice(&dev);
        (void)hipDeviceGetAttribute(&cus, hipDeviceAttributeMultiprocessorCount, dev);
        (void)hipFuncSetAttribute((const void*)mega_fwd, hipFuncAttributeMaxDynamicSharedMemorySize, LDS_BYTES);
        (void)hipOccupancyMaxActiveBlocksPerMultiprocessor(&per_cu, (const void*)mega_fwd, NTHREADS, LDS_BYTES);
        grid_blocks = cus;
        if (per_cu < 1 || ws_size < WS_END || n_in != 30) { fprintf(stderr, "kernel_launch: per_cu=%d ws=%zu n_in=%d: cannot run\n", per_cu, ws_size, n_in); grid_blocks = -1; }
    }
    if (grid_blocks < 0) return;
    (void)hipMemsetAsync(d_ws, 0, 65536, stream);
    static const void* ptrs[32];
    for (int i = 0; i < 30; ++i) ptrs[i] = d_in[i];
    ptrs[30] = d_out; ptrs[31] = d_ws;
    void* args[32];
    for (int i = 0; i < 32; ++i) args[i] = (void*)&ptrs[i];
    hipError_t e = hipLaunchCooperativeKernel((const void*)mega_fwd, dim3(grid_blocks), dim3(NTHREADS), args, LDS_BYTES, stream);
    if (e != hipSuccess) fprintf(stderr, "cooperative launch failed: %s (grid %d)\n", hipGetErrorString(e), grid_blocks);
}
```

```cpp
#include <hip/hip_runtime.h>
#include <hip/hip_cooperative_groups.h>
#include <cstdio>
#include <cstdint>
namespace cg = cooperative_groups;

#define LAS __attribute__((address_space(3)))
#define GAS __attribute__((address_space(1)))
typedef unsigned short bf16_t;
typedef short bf16x8 __attribute__((ext_vector_type(8)));
typedef short s16x4 __attribute__((ext_vector_type(4)));
typedef float f32x2 __attribute__((ext_vector_type(2)));
typedef float f32x4 __attribute__((ext_vector_type(4)));
typedef float f32x16 __attribute__((ext_vector_type(16)));
typedef unsigned u32x2 __attribute__((ext_vector_type(2)));
typedef unsigned u32x4 __attribute__((ext_vector_type(4)));

constexpr int NTHREADS = 512, NWAVES = 8;
constexpr int LDS_BYTES = 147456;
constexpr int BATCH = 4, SEQ = 8192, DM = 1024, NTOK = BATCH * SEQ;
constexpr int PROJ_W = 4352;
constexpr int NIN = 6656;
constexpr int C_DAQ = 0, C_DAK = 1024, C_DAV = 2048, C_NQ = 3072, C_CK = 3584, C_CV = 3712, C_SK = 3840, C_SV = 3968, C_WK = 4096, C_WV = 4224;
constexpr int NEXP = 64, EH = 256, CAP = NTOK;
constexpr int NSPLIT = 2, YW = DM / NSPLIT;
constexpr float LOG2E = 1.4426950408889634f;
constexpr float QSCALE = 0.125f * LOG2E;
constexpr float NEG_INF = -__builtin_huge_valf();

constexpr size_t MiB = 1u << 20, KiB = 1024;
constexpr size_t WS_CTL = 0;
constexpr int CW_P0Q = 80;
constexpr int CW_P1Q = 81;
constexpr int CW_CMBQ = 82;
constexpr int CW_KCMAX = 96;
constexpr size_t WS_BAR = 16 * KiB;
constexpr size_t WS_MOD = 64 * KiB;
constexpr size_t WS_KSN = 240 * KiB;
constexpr size_t WS_RBIAS = 160 * KiB;
constexpr size_t WS_KTN = 192 * KiB;
constexpr size_t WS_RSLOT = 1 * MiB;
constexpr size_t WS_RW = 9 * MiB;
constexpr size_t WS_WDN = 17 * MiB;
constexpr size_t WS_SHDN = 49 * MiB;
constexpr size_t WS_WGU = 50 * MiB;
constexpr size_t WS_SHGU = 114 * MiB;
constexpr size_t WS_WIN = 115 * MiB;
constexpr size_t WS_WDA = 128 * MiB;
constexpr size_t WS_WNSA = 130 * MiB;
constexpr size_t WS_WO = 131 * MiB;
constexpr size_t WS_CKW1 = 133 * MiB;
constexpr size_t WS_CVW1 = 133 * MiB + 512 * KiB;
constexpr size_t WS_CKW2 = 134 * MiB;
constexpr size_t WS_CVW2 = 134 * MiB + 64 * KiB;
constexpr size_t WS_RHI = 134 * MiB + 128 * KiB;
constexpr size_t WS_RLO = 134 * MiB + 256 * KiB;
constexpr size_t WS_KC = 135 * MiB;
constexpr size_t WS_VC = 135 * MiB + 512 * KiB;
constexpr size_t WS_NSAG = 136 * MiB;
constexpr size_t WS_XN = 140 * MiB;
constexpr size_t WS_PROJ = 204 * MiB;
constexpr size_t WS_OB = 476 * MiB;
constexpr size_t WS_MERGED = 204 * MiB;
constexpr size_t WS_LO = 268 * MiB;
constexpr size_t WS_ACT = 367 * MiB;
constexpr size_t WS_YS = 50 * MiB;
constexpr size_t WS_END = 512 * MiB;

struct Params { const float* in[30]; float* out; unsigned char* ws; };

__device__ __forceinline__ unsigned f2bf(float f) { unsigned u = __builtin_bit_cast(unsigned, f); return (u + 0x7fffu + ((u >> 16) & 1u)) >> 16; }
typedef __bf16 bf16x2_t __attribute__((ext_vector_type(2)));
__device__ __forceinline__ unsigned pk2(float lo, float hi) { f32x2 v = {lo, hi}; bf16x2_t b = __builtin_convertvector(v, bf16x2_t); return __builtin_bit_cast(unsigned, b); }
__device__ __forceinline__ float bf2f(unsigned short b) { return __builtin_bit_cast(float, (unsigned)b << 16); }
__device__ __forceinline__ float bflo(unsigned w) { return __builtin_bit_cast(float, w << 16); }
__device__ __forceinline__ float bfhi(unsigned w) { return __builtin_bit_cast(float, w & 0xffff0000u); }
__device__ __forceinline__ float wave_sum(float v) {
#pragma unroll
    for (int o = 1; o < 64; o <<= 1) v += __shfl_xor(v, o);
    return v;
}
__device__ __forceinline__ float fast_exp2(float x) { return __builtin_amdgcn_exp2f(x); }
__device__ __forceinline__ float sigmoidf_(float x) { return __builtin_amdgcn_rcpf(1.0f + __builtin_amdgcn_exp2f(-LOG2E * x)); }
__device__ __forceinline__ u32x4 pair_swap_store(unsigned a0, unsigned a1, unsigned b0, unsigned b1) {
    auto r0 = __builtin_amdgcn_permlane32_swap(a0, b0, false, false); auto r1 = __builtin_amdgcn_permlane32_swap(a1, b1, false, false);
    return (u32x4){r0[0], r1[0], r0[1], r1[1]};
}
__device__ __forceinline__ float swap32_max(float v) { auto rr = __builtin_amdgcn_permlane32_swap(__float_as_uint(v), __float_as_uint(v), false, false); return fmaxf(__uint_as_float(rr[0]), __uint_as_float(rr[1])); }
__device__ __forceinline__ float swap32_sum(float v) { auto rr = __builtin_amdgcn_permlane32_swap(__float_as_uint(v), __float_as_uint(v), false, false); return __uint_as_float(rr[0]) + __uint_as_float(rr[1]); }
__device__ __forceinline__ s16x4 tr_read(LAS const unsigned char* p) { typedef short v4i16_t __attribute__((ext_vector_type(4))); return __builtin_bit_cast(s16x4, __builtin_amdgcn_ds_read_tr16_b64_v4i16((LAS v4i16_t*)p)); }
__device__ __forceinline__ bf16x8 pack8(const f32x16& p, int b) {
    u32x4 w; w.x = pk2(p[b], p[b + 1]); w.y = pk2(p[b + 2], p[b + 3]); w.z = pk2(p[b + 4], p[b + 5]); w.w = pk2(p[b + 6], p[b + 7]);
    return __builtin_bit_cast(bf16x8, w);
}
#define CR(r) (((r) & 3) + 8 * ((r) >> 2))
template <int CTRL> __device__ __forceinline__ int dpp_i(int v) { return __builtin_amdgcn_update_dpp(v, v, CTRL, 0xf, 0xf, false); }
template <int CTRL> __device__ __forceinline__ float dpp_f(float v) { return __int_as_float(__builtin_amdgcn_update_dpp(__float_as_int(v), __float_as_int(v), CTRL, 0xf, 0xf, false)); }
constexpr int DPP_XOR1 = 0xB1, DPP_XOR2 = 0x4E, DPP_HMIRROR = 0x141, DPP_ROR8 = 0x128;

namespace pg8 {
constexpr int BM = 256, BK = 64, HALF = 128, HTB = HALF * BK * 2, STAGE_BYTES = 8 * HTB, NXCD = 8, WGM = 8;
__host__ __device__ __forceinline__ int lds_byte(int r, int c) { const int st = (r >> 4) * 2 + (c >> 5), rr = r & 15, cc = c & 31, ob = rr * 64 + cc * 2; return st * 1024 + (ob ^ (((ob >> 9) & 1) << 5)); }
__host__ __device__ __forceinline__ void stage_rc(int b, int& R, int& C) { const int st = b / 1024, sb = b % 1024, swz = sb ^ (((sb >> 9) & 1) << 5); R = (st >> 1) * 16 + swz / 64; C = (st & 1) * 32 + (swz % 64) / 2; }
__host__ __device__ __forceinline__ int perm32(int rho) { const int n = rho >> 4, i = rho & 15; return 8 * (i >> 2) + 4 * n + (i & 3); }

struct Unit { int arow; int bt; int x; int y; };
struct Gemm { const bf16_t* A; const bf16_t* Bt; int K; };

struct DenseSched {
    int nM, nN, nwg, G, c, bt0;
    __device__ void init(int M, int N, int G_, int c_, int bt0_ = 0) { nM = M / BM; nN = N / BM; nwg = nM * nN; G = G_; c = c_; bt0 = bt0_; }
    __device__ bool next(int i, Unit& u) const {
        const long L = (long)i * G + c; if (L >= nwg) return false;
        int wgid = (int)L; { const int q = nwg / NXCD, r = nwg % NXCD, xcd = wgid % NXCD, off = wgid / NXCD; wgid = (xcd < r ? xcd * (q + 1) : r * (q + 1) + (xcd - r) * q) + off; }
        const int nig = WGM * nN, gid = wgid / nig, fm = gid * WGM, gsz = (nM - fm) < WGM ? (nM - fm) : WGM;
        const int pm = fm + ((wgid % nig) % gsz), pn = (wgid % nig) / gsz;
        u.arow = pm * BM; u.bt = bt0 + pn; u.x = pm; u.y = pn; return true;
    }
    __device__ __forceinline__ int row(const Unit&, int) const { return 0; }
};
struct ExpertSched {
    const LAS int* tstart; const LAS int* astart; const LAS unsigned char* texp; const int* rowslot; int ntile, npn, btmul, btadd, G, c;
    __device__ bool next(int i, Unit& u) const {
        const int per = G >> 3; const int L = (G & 7) ? i * G + c : ((i * 8 + (c & 7)) * per + (c >> 3)); if (L >= ntile * npn) return false;
        const int mtg = L / npn, pn = L - mtg * npn; const int e = texp[mtg];
        const int mt = mtg - tstart[e];
        u.x = e; u.y = mt | (pn << 16); u.bt = e * btmul + btadd + pn; u.arow = astart[e] + 256 * mt; return true;
    }
    __device__ __forceinline__ int row(const Unit& u, int r) const {
        const int e = u.x, cnt = astart[e + 1] - astart[e]; int pos = 256 * (u.y & 0xffff) + r; pos = pos < cnt ? pos : cnt - 1;
        const int v = rowslot[(size_t)(e < 64 ? e : 0) * CAP + pos] >> 3;
        return e < 64 ? v : pos;
    }
};

#ifndef PG8_SP2
#define PG8_SP2 true
#endif
template <class Epi, class Sched, bool GATHER, bool SP2 = PG8_SP2>
__device__ __forceinline__ void gemm_phase(LAS unsigned char* lds, const Gemm g, const Sched& S, const Epi& E) {
    int tid_ = threadIdx.x; asm volatile("" : "+v"(tid_));
    const int tid = tid_, wid = __builtin_amdgcn_readfirstlane(tid >> 6), lane = tid & 63, wr = wid >> 2, wc = wid & 3, fr = lane & 15, fq = lane >> 4;
    const int K = g.K, nt = K / BK;
    int Rr[2], Cc[2]; unsigned voffB[2], oc[2][2], on[2][2];
#pragma unroll
    for (int i = 0; i < 2; ++i) { int R, C; stage_rc(tid * 16 + i * 8192, R, C); Rr[i] = R; Cc[i] = C; const int Rb0 = Epi::PERM ? ((R & ~31) + perm32(R & 31)) : R; const int Rb = Epi::COLPAIR ? (64 * (Rb0 >> 5) + (Rb0 & 31)) : Rb0;
        voffB[i] = (unsigned)(Rb * K + C) * 2u; }
    const unsigned kstep = (unsigned)(BK * 2);
    const unsigned tstep = 2u * (unsigned)(HALF * K * 2);
    const unsigned hstep = Epi::COLPAIR ? (unsigned)(32 * K * 2) : (unsigned)(HALF * K * 2);
    const __amdgpu_buffer_rsrc_t rsA = __builtin_amdgcn_make_buffer_rsrc((void*)g.A, 0, 0x7fffffff, 0x00020000), rsB = __builtin_amdgcn_make_buffer_rsrc((void*)g.Bt, 0, 0x7fffffff, 0x00020000);
    const unsigned ldsw = (unsigned)wid * 1024u;
    const int aoff = lds_byte(wr * 64 + fr, fq * 8), boff = lds_byte(wc * 32 + fr, fq * 8);
#define PG8_SA(b, h) (((b) * 2 + (h)) * HTB)
#define PG8_SB(b, h) ((4 + (b) * 2 + (h)) * HTB)
#define PG8_STAGE_(rs, bufoff, soff, voff) do { _Pragma("unroll") for (int _i = 0; _i < 2; ++_i) \
        __builtin_amdgcn_raw_ptr_buffer_load_lds(rs, (LAS void*)(lds + (bufoff) + ldsw + _i * 8192), 16, (voff)[_i], (soff), 0, 0); } while (0)
#define PG8_STAGE_A(bufoff, soff, voff) PG8_STAGE_(rsA, bufoff, soff, voff)
#define PG8_STAGE_B(bufoff, soff, voff) PG8_STAGE_(rsB, bufoff, soff, voff)
#define PG8_LDA(dst, b, h) do { _Pragma("unroll") for (int m = 0; m < 4; ++m) _Pragma("unroll") for (int k = 0; k < 2; ++k) dst[m][k] = *(const LAS bf16x8*)(lds + PG8_SA(b, h) + aoff + m * 2048 + k * 1024); } while (0)
#define PG8_LDB(dst, b, h) do { _Pragma("unroll") for (int n = 0; n < 2; ++n) _Pragma("unroll") for (int k = 0; k < 2; ++k) dst[n][k] = *(const LAS bf16x8*)(lds + PG8_SB(b, h) + boff + n * 2048 + k * 1024); } while (0)
#define PG8_MMA(ai, bj, At, Bt) do { __builtin_amdgcn_s_setprio(1); _Pragma("unroll") for (int m = 0; m < 4; ++m) _Pragma("unroll") for (int n = 0; n < 2; ++n) _Pragma("unroll") for (int k = 0; k < 2; ++k) \
        acc[ai][bj][m][n] = __builtin_amdgcn_mfma_f32_16x16x32_bf16(Bt[n][k], At[m][k], acc[ai][bj][m][n], 0, 0, 0); __builtin_amdgcn_s_setprio(0); } while (0)
#define PG8_WAIT_V(n) asm volatile("s_waitcnt vmcnt(" #n ")" ::: "memory")
#define PG8_WAIT_L(n) asm volatile("s_waitcnt lgkmcnt(" #n ")" ::: "memory")
#define PG8_BAR __builtin_amdgcn_s_barrier()
#define PG8_SCHED __builtin_amdgcn_sched_barrier(0)
#define PG8_OFFS(dst, u) do { _Pragma("unroll") for (int h = 0; h < 2; ++h) _Pragma("unroll") for (int i = 0; i < 2; ++i) \
        dst[h][i] = GATHER ? (unsigned)((unsigned)S.row(u, 128 * h + Rr[i]) * (unsigned)K + (unsigned)Cc[i]) * 2u : (unsigned)((128 * h + Rr[i]) * K + Cc[i]) * 2u; } while (0)
    Unit cur, nxt; int ui = 0;
    if (!S.next(0, cur)) return;
    f32x4 acc[2][2][4][2];
#pragma unroll
    for (int a = 0; a < 2; ++a)
#pragma unroll
        for (int b = 0; b < 2; ++b)
#pragma unroll
            for (int m = 0; m < 4; ++m)
#pragma unroll
                for (int n = 0; n < 2; ++n) acc[a][b][m][n] = (f32x4){0.f, 0.f, 0.f, 0.f};
    bf16x8 At[4][2], B0[2][2], B1[2][2];
    typename Epi::Pre pre; E.prefetch(pre, cur, wr, fr);
    PG8_OFFS(oc, cur);
    unsigned cA = GATHER ? 0u : (unsigned)cur.arow * (unsigned)K * 2u, cB = (unsigned)cur.bt * tstep;
    if constexpr (SP2) {
    PG8_STAGE_B(PG8_SB(0, 0), cB, voffB); PG8_STAGE_B(PG8_SB(0, 1), cB + hstep, voffB); PG8_STAGE_A(PG8_SA(0, 0), cA, oc[0]); PG8_STAGE_A(PG8_SA(0, 1), cA, oc[1]);
    if (wr == 1) PG8_BAR;
    PG8_WAIT_V(2); PG8_BAR;
    PG8_STAGE_B(PG8_SB(1, 0), cB + kstep, voffB); PG8_STAGE_A(PG8_SA(1, 0), cA + kstep, oc[0]); PG8_STAGE_B(PG8_SB(1, 1), cB + hstep + kstep, voffB);
    PG8_WAIT_V(6); PG8_BAR;
    } else {
    PG8_STAGE_B(PG8_SB(0, 0), cB, voffB); PG8_STAGE_A(PG8_SA(0, 0), cA, oc[0]); PG8_STAGE_B(PG8_SB(0, 1), cB + hstep, voffB); PG8_STAGE_A(PG8_SA(0, 1), cA, oc[1]);
    if (wr == 1) PG8_BAR;
    PG8_WAIT_V(4); PG8_BAR;
    PG8_STAGE_B(PG8_SB(1, 0), cB + kstep, voffB); PG8_STAGE_A(PG8_SA(1, 0), cA + kstep, oc[0]); PG8_STAGE_B(PG8_SB(1, 1), cB + hstep + kstep, voffB);
    PG8_WAIT_V(6); PG8_BAR;
    }
    for (;;) {
        const bool has_next = S.next(ui + 1, nxt);
        const unsigned nA = has_next ? (GATHER ? 0u : (unsigned)nxt.arow * (unsigned)K * 2u) : cA, nB = has_next ? (unsigned)nxt.bt * tstep : cB;
        if (GATHER) { if (has_next) { PG8_OFFS(on, nxt); } else {
#pragma unroll
            for (int h = 0; h < 2; ++h)
#pragma unroll
                for (int i = 0; i < 2; ++i) on[h][i] = oc[h][i]; } }
#pragma unroll 1
        for (int t = 0; t < nt; t += 2) {
            const bool last = (t == nt - 2);
            const unsigned a1 = cA + (unsigned)(t + 1) * kstep;
            const unsigned a2 = last ? nA : cA + (unsigned)(t + 2) * kstep, b2 = last ? nB : cB + (unsigned)(t + 2) * kstep;
            const unsigned a3 = a2 + kstep, b3 = b2 + kstep;
            unsigned o2[2][2];
#pragma unroll
            for (int h = 0; h < 2; ++h)
#pragma unroll
                for (int i = 0; i < 2; ++i) o2[h][i] = (GATHER && last) ? on[h][i] : oc[h][i];
            if constexpr (SP2) {
            PG8_LDB(B0, 0, 0); PG8_LDB(B1, 0, 1); PG8_SCHED; PG8_LDA(At, 0, 0); PG8_STAGE_A(PG8_SA(1, 1), a1, oc[1]);
            PG8_WAIT_V(8); PG8_WAIT_L(0); PG8_BAR; PG8_MMA(0, 0, At, B0); PG8_MMA(0, 1, At, B1); PG8_BAR; PG8_SCHED;
            PG8_LDA(At, 0, 1); PG8_STAGE_B(PG8_SB(0, 0), b2, voffB); PG8_STAGE_B(PG8_SB(0, 1), b2 + hstep, voffB); PG8_STAGE_A(PG8_SA(0, 0), a2, o2[0]);
            PG8_WAIT_V(8); PG8_WAIT_L(0); PG8_BAR; PG8_MMA(1, 0, At, B0); PG8_MMA(1, 1, At, B1); PG8_BAR; PG8_SCHED;
            PG8_LDB(B0, 1, 0); PG8_LDB(B1, 1, 1); PG8_SCHED; PG8_LDA(At, 1, 0); PG8_STAGE_A(PG8_SA(0, 1), a2, o2[1]);
            PG8_WAIT_V(8); PG8_WAIT_L(0); PG8_BAR; PG8_MMA(0, 0, At, B0); PG8_MMA(0, 1, At, B1); PG8_BAR; PG8_SCHED;
            PG8_LDA(At, 1, 1); PG8_STAGE_B(PG8_SB(1, 0), b3, voffB); PG8_STAGE_B(PG8_SB(1, 1), b3 + hstep, voffB); PG8_STAGE_A(PG8_SA(1, 0), a3, o2[0]);
            PG8_WAIT_V(8); PG8_WAIT_L(0); PG8_BAR; PG8_MMA(1, 0, At, B0); PG8_MMA(1, 1, At, B1); PG8_BAR; PG8_SCHED;
                    } else {
            PG8_LDB(B0, 0, 0); PG8_SCHED; PG8_LDA(At, 0, 0); PG8_STAGE_A(PG8_SA(1, 1), a1, oc[1]);
            PG8_WAIT_L(8); PG8_BAR; PG8_WAIT_L(0); PG8_MMA(0, 0, At, B0); PG8_BAR; PG8_SCHED;
            PG8_LDB(B1, 0, 1); PG8_STAGE_B(PG8_SB(0, 0), b2, voffB);
            PG8_BAR; PG8_WAIT_L(0); PG8_MMA(0, 1, At, B1); PG8_BAR;
            PG8_LDA(At, 0, 1); PG8_STAGE_A(PG8_SA(0, 0), a2, o2[0]);
            PG8_BAR; PG8_WAIT_L(0); PG8_MMA(1, 0, At, B0); PG8_BAR; PG8_SCHED;
            PG8_STAGE_B(PG8_SB(0, 1), b2 + hstep, voffB);
            PG8_WAIT_V(6); PG8_BAR; PG8_MMA(1, 1, At, B1); PG8_BAR;
            PG8_LDB(B0, 1, 0); PG8_SCHED; PG8_LDA(At, 1, 0); PG8_STAGE_A(PG8_SA(0, 1), a2, o2[1]);
            PG8_WAIT_L(8); PG8_BAR; PG8_WAIT_L(0); PG8_MMA(0, 0, At, B0); PG8_BAR; PG8_SCHED;
            PG8_LDB(B1, 1, 1); PG8_STAGE_B(PG8_SB(1, 0), b3, voffB);
            PG8_BAR; PG8_WAIT_L(0); PG8_MMA(0, 1, At, B1); PG8_BAR;
            PG8_LDA(At, 1, 1); PG8_STAGE_A(PG8_SA(1, 0), a3, o2[0]);
            PG8_BAR; PG8_WAIT_L(0); PG8_MMA(1, 0, At, B0); PG8_BAR; PG8_SCHED;
            PG8_STAGE_B(PG8_SB(1, 1), b3 + hstep, voffB);
            PG8_WAIT_V(6); PG8_BAR; PG8_MMA(1, 1, At, B1); PG8_BAR;
            }
        }
        if (wr == 0) PG8_BAR;
        E(acc, cur, wr, wc, fr, fq, pre);
        if (!has_next) break;
#pragma unroll
        for (int a = 0; a < 2; ++a)
#pragma unroll
            for (int b = 0; b < 2; ++b)
#pragma unroll
                for (int m = 0; m < 4; ++m)
#pragma unroll
                    for (int n = 0; n < 2; ++n) acc[a][b][m][n] = (f32x4){0.f, 0.f, 0.f, 0.f};
        cur = nxt; cA = nA; cB = nB; ++ui;
        E.prefetch(pre, cur, wr, fr);
#pragma unroll
        for (int h = 0; h < 2; ++h)
#pragma unroll
            for (int i = 0; i < 2; ++i) oc[h][i] = GATHER ? on[h][i] : oc[h][i];
        if (wr == 1) PG8_BAR;
    }
    PG8_WAIT_V(0);
    PG8_BAR;
#undef PG8_SA
#undef PG8_SB
#undef PG8_STAGE_
#undef PG8_STAGE_A
#undef PG8_STAGE_B
#undef PG8_LDA
#undef PG8_LDB
#undef PG8_MMA
#undef PG8_WAIT_V
#undef PG8_WAIT_L
#undef PG8_BAR
#undef PG8_SCHED
#undef PG8_OFFS
}
}
using pg8::Unit;
typedef f32x4 AccT[2][2][4][2];

struct EpiProj {
    static constexpr bool PERM = true;
    struct Pre {}; __device__ __forceinline__ void prefetch(Pre&, const Unit&, int, int) const {}
    static constexpr bool COLPAIR = true;
    bf16_t* proj; bf16_t* gates; float* nsag;
    __device__ __forceinline__ void operator()(const AccT& acc, const Unit& u, int wr, int wc, int fr, int fq, const Pre& pre) const {
        const int pn = u.y, row0 = u.arow + wr * 64 + fr;
        if (pn == 25) {
            if (wc == 0 && fq < 3) {
#pragma unroll
                for (int ai = 0; ai < 2; ++ai)
#pragma unroll
                    for (int m = 0; m < 4; ++m) { float* o = nsag + (size_t)(row0 + ai * 128 + m * 16) * 24 + 8 * fq;
                        const f32x4 v0 = acc[ai][0][m][0], v1 = acc[ai][0][m][1];
                        *(f32x4*)o = (f32x4){sigmoidf_(v0[0]), sigmoidf_(v0[1]), sigmoidf_(v0[2]), sigmoidf_(v0[3])};
                        *(f32x4*)(o + 4) = (f32x4){sigmoidf_(v1[0]), sigmoidf_(v1[1]), sigmoidf_(v1[2]), sigmoidf_(v1[3])}; }
            }
            return;
        }
        const bool gate = pn >= 17;
        const float sc = (pn < 4 || pn == 12 || pn == 13) ? QSCALE : 1.0f;
        bf16_t* base = gate ? gates : proj; const int ldc = gate ? 2048 : PROJ_W; const int col0 = (gate ? (pn - 17) : pn) * 256 + wc * 64 + 8 * fq;
#pragma unroll
        for (int ai = 0; ai < 2; ++ai)
#pragma unroll
            for (int m = 0; m < 4; ++m) { bf16_t* rowp = base + (size_t)(row0 + ai * 128 + m * 16) * ldc + col0;
#pragma unroll
                for (int bj = 0; bj < 2; ++bj) { f32x4 v0 = acc[ai][bj][m][0], v1 = acc[ai][bj][m][1];
                    if (gate) {
#pragma unroll
                        for (int j = 0; j < 4; ++j) { v0[j] = sigmoidf_(v0[j]); v1[j] = sigmoidf_(v1[j]); } }
                    else { v0 = v0 * sc; v1 = v1 * sc; }
                    u32x4 w; w.x = pk2(v0[0], v0[1]); w.y = pk2(v0[2], v0[3]); w.z = pk2(v1[0], v1[1]); w.w = pk2(v1[2], v1[3]);
                    __builtin_nontemporal_store(w, (u32x4*)(rowp + bj * 32)); } }
    }
};
template <bool ADD> struct EpiGate {
    static constexpr bool PERM = true;
    struct Pre {}; __device__ __forceinline__ void prefetch(Pre&, const Unit&, int, int) const {}
    static constexpr bool COLPAIR = false;
    bf16_t* merged; const bf16_t* gates; int goff;
    __device__ __forceinline__ void operator()(const AccT& acc, const Unit& u, int wr, int wc, int fr, int fq, const Pre& pre) const {
        const int row0 = u.arow + wr * 64 + fr, col0 = u.y * 256 + wc * 32 + 8 * fq;
        const __amdgpu_buffer_rsrc_t rg = __builtin_amdgcn_make_buffer_rsrc((void*)gates, 0, NTOK * 2048 * 2, 0x00020000);
        const unsigned vg = (unsigned)(row0 * 2048 + goff + col0) * 2u;
#pragma unroll
        for (int ai = 0; ai < 2; ++ai) { u32x4 gq[4][2];
#pragma unroll
            for (int m = 0; m < 4; ++m)
#pragma unroll
                for (int bj = 0; bj < 2; ++bj) gq[m][bj] = __builtin_bit_cast(u32x4, __builtin_amdgcn_raw_buffer_load_b128(rg, vg, ((ai * 128 + m * 16) * 2048 + bj * 128) * 2, 0));
#pragma unroll
            for (int m = 0; m < 4; ++m) { const size_t r = (size_t)(row0 + ai * 128 + m * 16);
#pragma unroll
                for (int bj = 0; bj < 2; ++bj) { const int c = col0 + bj * 128; const u32x4 gv = gq[m][bj];
                    f32x4 v0 = acc[ai][bj][m][0], v1 = acc[ai][bj][m][1];
                    v0[0] *= bflo(gv.x); v0[1] *= bfhi(gv.x); v0[2] *= bflo(gv.y); v0[3] *= bfhi(gv.y);
                    v1[0] *= bflo(gv.z); v1[1] *= bfhi(gv.z); v1[2] *= bflo(gv.w); v1[3] *= bfhi(gv.w);
                    if (ADD) { const u32x4 pv = *(const u32x4*)(merged + r * DM + c);
                        v0[0] += bflo(pv.x); v0[1] += bfhi(pv.x); v0[2] += bflo(pv.y); v0[3] += bfhi(pv.y);
                        v1[0] += bflo(pv.z); v1[1] += bfhi(pv.z); v1[2] += bflo(pv.w); v1[3] += bfhi(pv.w); }
                    u32x4 w; w.x = pk2(v0[0], v0[1]); w.y = pk2(v0[2], v0[3]); w.z = pk2(v1[0], v1[1]); w.w = pk2(v1[2], v1[3]);
                    *(u32x4*)(merged + r * DM + c) = w; } } }
    }
};
struct EpiResid {
    static constexpr bool PERM = false;
    struct Pre {}; __device__ __forceinline__ void prefetch(Pre&, const Unit&, int, int) const {}
    static constexpr bool COLPAIR = false;
    const float* x; const float* mod; float* out; float* ssq;
    __device__ __forceinline__ void operator()(const AccT& acc, const Unit& u, int wr, int wc, int fr, int fq, const Pre& pre) const {
        const int row0 = u.arow + wr * 64 + fr, col0 = u.y * 256 + wc * 32 + 4 * fq; const int b = u.arow / SEQ;
        const float* g1 = mod + (size_t)b * 6144 + 2048;
        float sq[2][4];
#pragma unroll
        for (int ai = 0; ai < 2; ++ai)
#pragma unroll
            for (int m = 0; m < 4; ++m) sq[ai][m] = 0.f;
        const __amdgpu_buffer_rsrc_t rx = __builtin_amdgcn_make_buffer_rsrc((void*)x, 0, NTOK * DM * 4, 0x00020000), ro = __builtin_amdgcn_make_buffer_rsrc((void*)out, 0, NTOK * DM * 4, 0x00020000);
        const unsigned vo = (unsigned)(row0 * DM + col0) * 4u;
#pragma unroll
        for (int bj = 0; bj < 2; ++bj) { f32x4 xv[2][2][4];
#pragma unroll
            for (int n = 0; n < 2; ++n)
#pragma unroll
                for (int ai = 0; ai < 2; ++ai)
#pragma unroll
                    for (int m = 0; m < 4; ++m) xv[n][ai][m] = __builtin_bit_cast(f32x4, __builtin_amdgcn_raw_buffer_load_b128(rx, vo, ((ai * 128 + m * 16) * DM + bj * 128 + n * 16) * 4, 0));
            __builtin_amdgcn_sched_barrier(0);
#pragma unroll
            for (int n = 0; n < 2; ++n) { const int c = col0 + bj * 128 + n * 16; const f32x4 gv = *(const f32x4*)(g1 + c);
#pragma unroll
                for (int ai = 0; ai < 2; ++ai)
#pragma unroll
                    for (int m = 0; m < 4; ++m) {
                        const f32x4 o = xv[n][ai][m] + gv * acc[ai][bj][m][n];
                        __builtin_amdgcn_raw_buffer_store_b128(__builtin_bit_cast(u32x4, o), ro, vo, ((ai * 128 + m * 16) * DM + bj * 128 + n * 16) * 4, 0);
                        sq[ai][m] += (o.x * o.x + o.y * o.y) + (o.z * o.z + o.w * o.w); } } }
        float* sp = ssq + (size_t)(u.y * 4 + wc) * NTOK + row0;
#pragma unroll
        for (int ai = 0; ai < 2; ++ai)
#pragma unroll
            for (int m = 0; m < 4; ++m) { float t = sq[ai][m]; t += __shfl_xor(t, 16); t += __shfl_xor(t, 32); if (fq == 0) sp[ai * 128 + m * 16] = t; }
    }
};
struct EpiAct {
    static constexpr bool PERM = true;
    struct Pre {}; __device__ __forceinline__ void prefetch(Pre&, const Unit&, int, int) const {}
    static constexpr bool COLPAIR = false;
    bf16_t* act; const LAS int* astart;
    __device__ __forceinline__ void operator()(const AccT& acc, const Unit& u, int wr, int wc, int fr, int fq, const Pre& pre) const {
        const int e = u.x, mt = u.y & 0xffff, pn = u.y >> 16, rbase = u.arow, nvalid = (astart[e + 1] - astart[e]) - 256 * mt;
        const int col0 = pn * 128 + wc * 32 + 8 * fq;
#pragma unroll
        for (int ai = 0; ai < 2; ++ai)
#pragma unroll
            for (int m = 0; m < 4; ++m) { const int lr = ai * 128 + wr * 64 + m * 16 + fr;
                if (lr < nvalid) {
                    const f32x4 g0 = acc[ai][0][m][0], g1 = acc[ai][0][m][1], u0 = acc[ai][1][m][0], u1 = acc[ai][1][m][1]; float a[8];
#pragma unroll
                    for (int j = 0; j < 4; ++j) { a[j] = g0[j] * sigmoidf_(g0[j]) * u0[j]; a[4 + j] = g1[j] * sigmoidf_(g1[j]) * u1[j]; }
                    u32x4 w; w.x = pk2(a[0], a[1]); w.y = pk2(a[2], a[3]); w.z = pk2(a[4], a[5]); w.w = pk2(a[6], a[7]);
                    *(u32x4*)(act + (size_t)(rbase + lr) * EH + col0) = w; } }
    }
};
struct EpiDown {
    static constexpr bool PERM = true;
    struct Pre {}; __device__ __forceinline__ void prefetch(Pre&, const Unit&, int, int) const {}
    static constexpr bool COLPAIR = false;
    bf16_t* Y; const LAS int* astart;
    __device__ __forceinline__ void operator()(const AccT& acc, const Unit& u, int wr, int wc, int fr, int fq, const Pre& pre) const {
        const int e = u.x, mt = u.y & 0xffff, pn = u.y >> 16; const int nvalid = (astart[e + 1] - astart[e]) - 256 * mt;
        const int col0 = pn * 256 + wc * 32 + 8 * fq;
#pragma unroll
        for (int ai = 0; ai < 2; ++ai)
#pragma unroll
            for (int m = 0; m < 4; ++m) { const int lr = ai * 128 + wr * 64 + m * 16 + fr;
                if (lr < nvalid) {
                    bf16_t* rowp = Y + (size_t)(u.arow + lr) * YW + col0;
#pragma unroll
                    for (int bj = 0; bj < 2; ++bj) { const f32x4 v0 = acc[ai][bj][m][0], v1 = acc[ai][bj][m][1];
                        u32x4 o; o.x = pk2(v0[0], v0[1]); o.y = pk2(v0[2], v0[3]); o.z = pk2(v1[0], v1[1]); o.w = pk2(v1[2], v1[3]);
                        *(u32x4*)(rowp + bj * 128) = o; } } }
    }
};

#define XB_TMO      128
#define XB_XCNT(j)  (256  + 64 * (j))
#define XB_XSUB(j)  (1280 + 64 * (j))
#define XB_XGEN(j)  (2304 + 64 * (j))
#define XB_TOP      3328
#define XB_TOPGEN   3392
#define XCD_BAR_WORDS 3456
#define XB_SPIN_CAP (1u << 23)
__device__ __forceinline__ unsigned xb_ld(unsigned* p)              { return __hip_atomic_load(p, __ATOMIC_RELAXED, __HIP_MEMORY_SCOPE_AGENT); }
__device__ __forceinline__ unsigned xb_add(unsigned* p, unsigned v) { return __hip_atomic_fetch_add(p, v, __ATOMIC_RELAXED, __HIP_MEMORY_SCOPE_AGENT); }
__device__ __forceinline__ unsigned xb_xcc_id() { return (unsigned)__builtin_amdgcn_s_getreg((3 << 11) | 20) & 0xFu; }
#define XB_SPIN(cond, bar) do { unsigned _sp = 0; while (cond) { __builtin_amdgcn_s_sleep(1); \
    if ((++_sp & 255u) == 0u) { if (xb_ld(&(bar)[XB_TMO])) break; if (_sp > XB_SPIN_CAP) { atomicAdd(&(bar)[XB_TMO], 1u); break; } } } } while (0)
struct XcdBarrier { unsigned* bar; unsigned x; volatile LAS unsigned* st; };
__device__ __forceinline__ XcdBarrier xcd_barrier_post(unsigned* bar, volatile LAS unsigned* st) {
    XcdBarrier b; b.bar = bar; b.x = xb_xcc_id(); b.st = st;
    if (threadIdx.x == 0) (void)xb_add(&bar[XB_XCNT(b.x)], 1u);
    return b;
}
__device__ __forceinline__ void xcd_barrier_complete(unsigned* bar, unsigned x, unsigned& nloc, unsigned& nx) {
    const unsigned G = gridDim.x * gridDim.y * gridDim.z;
    unsigned sum, cnt, mine, sp = 0u;
    for (;;) {
        sum = 0u; cnt = 0u; mine = 0u;
#pragma unroll
        for (unsigned j = 0; j < 16; ++j) { const unsigned c = xb_ld(&bar[XB_XCNT(j)]); sum += c; cnt += (c > 0u) ? 1u : 0u; mine = (j == x) ? c : mine; }
        if (sum == G) break;
        __builtin_amdgcn_s_sleep(1);
        if ((++sp & 255u) == 0u) { if (xb_ld(&bar[XB_TMO])) break; if (sp > XB_SPIN_CAP) { atomicAdd(&bar[XB_TMO], 1u); break; } }
    }
    nloc = mine > 0u ? mine : 1u; nx = cnt > 0u ? cnt : 1u;
}
__device__ __forceinline__ void xcd_barrier(const XcdBarrier& b) {
    asm volatile("s_waitcnt vmcnt(0)" ::: "memory");
    __syncthreads();
    if (threadIdx.x == 0) {
        unsigned* bar = b.bar;
        __builtin_amdgcn_s_waitcnt(0);
        unsigned nloc = b.st[0], nx = b.st[1];
        if (nloc == 0u) { xcd_barrier_complete(bar, b.x, nloc, nx); b.st[0] = nloc; b.st[1] = nx; }
        const unsigned old = xb_add(&bar[XB_XSUB(b.x)], 1u);
        const unsigned gen = old / nloc;
        if (old + 1u == (gen + 1u) * nloc) {
            __builtin_amdgcn_fence(__ATOMIC_RELEASE, "agent");
            asm volatile("s_waitcnt vmcnt(0)" ::: "memory");
            const unsigned og = xb_add(&bar[XB_TOP], 1u);
            const unsigned tg = og / nx;
            if (og + 1u == (tg + 1u) * nx) xb_add(&bar[XB_TOPGEN], 1u);
            else XB_SPIN(xb_ld(&bar[XB_TOPGEN]) == tg, bar);
            __builtin_amdgcn_fence(__ATOMIC_ACQUIRE, "agent");
            xb_add(&bar[XB_XGEN(b.x)], 1u);
            asm volatile("s_waitcnt vmcnt(0)" ::: "memory");
        } else {
            XB_SPIN(xb_ld(&bar[XB_XGEN(b.x)]) == gen, bar);
            __builtin_amdgcn_fence(__ATOMIC_ACQUIRE, "agent");
            asm volatile("s_waitcnt vmcnt(0)" ::: "memory");
        }
    }
    __syncthreads();
}

struct Ctx {
    LAS unsigned char* lds; int tid, lane, wave, G, bid;
    const float* in[30]; float* out; unsigned char* ws;
    __device__ __forceinline__ const float* gin(int k) const { return in[k]; }
};

__device__ __forceinline__ int dest_row(int mode, int n) {
    if (mode == 1) return n < 4352 ? n : (n < 4376 ? 6400 + (n - 4352) : 4352 + (n - 4376));
    if (mode == 2) return (n >> 7) * 256 + (n & 127);
    if (mode == 3) return (n >> 7) * 256 + 128 + (n & 127);
    return n;
}
__device__ __forceinline__ void transpose_item(const float* W, int K, int N, bf16_t* WT, int mode, LAS float* scr, int item, int lane) {
    const int nblk = (N + 31) / 32, kb = item / nblk, nb = item % nblk, k0 = 64 * kb, n0 = 32 * nb;
    const int nn = n0 + (lane & 31);
    float tv[32];
#pragma unroll
    for (int i = 0; i < 32; ++i) { const int kk = 2 * i + (lane >> 5); tv[i] = nn < N ? __builtin_nontemporal_load(W + (size_t)(k0 + kk) * N + nn) : 0.f; }
#pragma unroll
    for (int i = 0; i < 32; ++i) { const int kk = 2 * i + (lane >> 5); scr[kk * 33 + (lane & 31)] = tv[i]; }
    asm volatile("s_waitcnt lgkmcnt(0)" ::: "memory");
    const int c = lane & 7;
#pragma unroll
    for (int j = 0; j < 4; ++j) { const int n = (lane >> 3) + 8 * j; const LAS float* s = scr + (8 * c) * 33 + n;
        u32x4 o; o.x = pk2(s[0 * 33], s[1 * 33]); o.y = pk2(s[2 * 33], s[3 * 33]); o.z = pk2(s[4 * 33], s[5 * 33]); o.w = pk2(s[6 * 33], s[7 * 33]);
        if (n0 + n < N) { const int nn_ = n0 + n, kk_ = k0 + 8 * c;
            const size_t di = mode == 4 ? (size_t)((((nn_ >> 4) * 64 + (kk_ >> 5)) * 64 + ((kk_ >> 3) & 3) * 16 + (nn_ & 15)) * 8) : (size_t)dest_row(mode, nn_) * K + kk_;
            *(u32x4*)(WT + di) = o; } }
    asm volatile("s_waitcnt lgkmcnt(0)" ::: "memory");
}
__device__ __forceinline__ void router_item(const float* W, bf16_t* HI, bf16_t* LO, LAS float* scr, int item, int lane) {
    const int kb = item / 2, nb = item % 2, k0 = 64 * kb, n0 = 32 * nb;
#pragma unroll 8
    for (int i = 0; i < 32; ++i) { const int kk = 2 * i + (lane >> 5); scr[kk * 33 + (lane & 31)] = W[(size_t)(k0 + kk) * 64 + n0 + (lane & 31)]; }
    asm volatile("s_waitcnt lgkmcnt(0)" ::: "memory");
    const int c = lane & 7;
#pragma unroll
    for (int j = 0; j < 4; ++j) { const int n = (lane >> 3) + 8 * j; const LAS float* s = scr + (8 * c) * 33 + n; unsigned h[8], l[8];
#pragma unroll
        for (int q = 0; q < 8; ++q) { const float v = s[q * 33]; h[q] = f2bf(v); l[q] = f2bf(v - __builtin_bit_cast(float, h[q] << 16)); }
        u32x4 oh, ol; oh.x = h[0] | (h[1] << 16); oh.y = h[2] | (h[3] << 16); oh.z = h[4] | (h[5] << 16); oh.w = h[6] | (h[7] << 16);
        ol.x = l[0] | (l[1] << 16); ol.y = l[2] | (l[3] << 16); ol.z = l[4] | (l[5] << 16); ol.w = l[6] | (l[7] << 16);
        const int e = n0 + n, kg = (k0 + 8 * c) >> 3; const size_t fo = (size_t)((((kg >> 4) * 4 + ((kg >> 2) & 3)) * 4 + (e >> 4)) * 2) * 512 + ((kg & 3) * 16 + (e & 15)) * 8;
        *(u32x4*)(HI + fo) = oh; *(u32x4*)(HI + fo + 512) = ol; }
    asm volatile("s_waitcnt lgkmcnt(0)" ::: "memory");
}
__device__ __forceinline__ void p0_prologue(const Ctx& C) {
    LAS float* scr = (LAS float*)(C.lds + C.wave * 16384);
    const int gw = C.bid * NWAVES + C.wave, NGW = C.G * NWAVES;
    unsigned char* ws = C.ws;
    constexpr int I_IN = 16 * 201, I_DA = 512, I_NSA = 256, I_O = 512, I_SG = 128, I_SU = 128, I_SD = 128,
                  I_K1 = 128, I_V1 = 128, I_K2 = 4, I_V2 = 4, I_R = 32, I_Z = 232;
    constexpr int NITEMS = I_IN + I_DA + I_NSA + I_O + I_SG + I_SU + I_SD + I_K1 + I_V1 + I_K2 + I_V2 + I_R + I_Z;
    if (C.bid < 96 || C.G < 96) {
        LAS float* red = (LAS float*)C.lds;
        LAS float* cact = (LAS float*)(C.lds + 16384);
        for (int i = C.tid; i < 4096; i += NTHREADS) { const float cv = C.gin(1)[i]; cact[i] = cv * sigmoidf_(cv); }
        __syncthreads();
        for (int cg0 = C.bid * 64; cg0 < 6144; cg0 += C.G * 64) {
            const float* cw = C.gin(2) + (size_t)(128 * C.wave) * 6144 + cg0 + C.lane; float a0 = 0.f, a1 = 0.f, a2 = 0.f, a3 = 0.f;
#pragma unroll 1
            for (int k0 = 0; k0 < 128; k0 += 32) { float wv[32];
#pragma unroll
                for (int j = 0; j < 32; ++j) wv[j] = cw[(size_t)(k0 + j) * 6144];
#pragma unroll
                for (int j = 0; j < 32; ++j) { const int kk = 128 * C.wave + k0 + j; a0 += cact[kk] * wv[j]; a1 += cact[1024 + kk] * wv[j]; a2 += cact[2048 + kk] * wv[j]; a3 += cact[3072 + kk] * wv[j]; } }
            *(LAS f32x4*)(red + (C.wave * 64 + C.lane) * 4) = (f32x4){a0, a1, a2, a3};
            __syncthreads();
            if (C.tid < 256) { const int b = C.tid >> 6, c2 = C.tid & 63; float sacc = 0.f;
#pragma unroll
                for (int w = 0; w < 8; ++w) sacc += red[(w * 64 + c2) * 4 + b];
                ((float*)(ws + WS_MOD))[b * 6144 + cg0 + c2] = sacc + C.gin(3)[cg0 + c2]; }
            __syncthreads();
            if (C.G >= 96) break;
        }
    }
    const bool split = C.G > 96; const int ngv = 96 * NWAVES;
    int it0, itend, itstep;
    if (!split) { it0 = gw; itend = NITEMS; itstep = NGW; }
    else if (C.bid < 96) { it0 = NITEMS - ngv + gw; itend = NITEMS; itstep = NITEMS; }
    else { it0 = gw - ngv; itend = NITEMS - ngv; itstep = NGW - ngv; }
    for (int it = it0; it < itend; it += itstep) {
        int r = it;
        if (r < I_IN) { transpose_item(C.gin(5), 1024, 6424, (bf16_t*)(ws + WS_WIN), 1, scr, r, C.lane); continue; } r -= I_IN;
        if (r < I_DA) { transpose_item(C.gin(17), 1024, 1024, (bf16_t*)(ws + WS_WDA), 0, scr, r, C.lane); continue; } r -= I_DA;
        if (r < I_NSA) { transpose_item(C.gin(18), 512, 1024, (bf16_t*)(ws + WS_WNSA), 0, scr, r, C.lane); continue; } r -= I_NSA;
        if (r < I_O) { transpose_item(C.gin(19), 1024, 1024, (bf16_t*)(ws + WS_WO), 0, scr, r, C.lane); continue; } r -= I_O;
        if (r < I_SG) { transpose_item(C.gin(26), 1024, 256, (bf16_t*)(ws + WS_SHGU), 2, scr, r, C.lane); continue; } r -= I_SG;
        if (r < I_SU) { transpose_item(C.gin(27), 1024, 256, (bf16_t*)(ws + WS_SHGU), 3, scr, r, C.lane); continue; } r -= I_SU;
        if (r < I_SD) { transpose_item(C.gin(28), 256, 1024, (bf16_t*)(ws + WS_SHDN), 0, scr, r, C.lane); continue; } r -= I_SD;
        if (r < I_K1) { transpose_item(C.gin(12), 2048, 128, (bf16_t*)(ws + WS_CKW1), 4, scr, r, C.lane); continue; } r -= I_K1;
        if (r < I_V1) { transpose_item(C.gin(15), 2048, 128, (bf16_t*)(ws + WS_CVW1), 4, scr, r, C.lane); continue; } r -= I_V1;
        if (r < I_K2) { transpose_item(C.gin(13), 128, 64, (bf16_t*)(ws + WS_CKW2), 0, scr, r, C.lane); continue; } r -= I_K2;
        if (r < I_V2) { transpose_item(C.gin(16), 128, 64, (bf16_t*)(ws + WS_CVW2), 0, scr, r, C.lane); continue; } r -= I_V2;
        if (r < I_R) { router_item(C.gin(21), (bf16_t*)(ws + WS_RHI), (bf16_t*)(ws + WS_RLO), scr, r, C.lane); continue; } r -= I_R;
        { u32x4* z = (u32x4*)((bf16_t*)(ws + WS_WIN) + (size_t)(6424 + r) * 1024); z[C.lane] = (u32x4){0u, 0u, 0u, 0u}; z[64 + C.lane] = (u32x4){0u, 0u, 0u, 0u}; }
    }
}

__device__ __forceinline__ void modulate_rows(const Ctx& C, const float* x, const float* nw, int sh_off, int sc_off, bf16_t* dst) {
    const float* mod = (const float*)(C.ws + WS_MOD);
    unsigned* qcnt = (unsigned*)(C.ws + WS_CTL) + CW_P1Q; LAS int* qw = (LAS int*)C.lds;
    if (C.tid == 0) qw[0] = (int)__hip_atomic_fetch_add(qcnt, 1u, __ATOMIC_RELAXED, __HIP_MEMORY_SCOPE_AGENT);
    __syncthreads();
#pragma unroll 1
    for (int n = 0;; ++n) {
        const int ch = qw[n & 1]; if (ch >= NTOK / 64) break;
        int nq_ = 0; if (C.tid == 0) nq_ = (int)__hip_atomic_fetch_add(qcnt, 1u, __ATOMIC_RELAXED, __HIP_MEMORY_SCOPE_AGENT);
        const int m0 = ch * 64 + C.wave * 8, b = m0 / SEQ;
        f32x4 v[8][4], w[4], sc[4], sh[4];
#pragma unroll
        for (int q = 0; q < 8; ++q) { const f32x4* xr = (const f32x4*)(x + (size_t)(m0 + q) * DM) + C.lane;
#pragma unroll
            for (int j = 0; j < 4; ++j) v[q][j] = __builtin_nontemporal_load(xr + 64 * j); }
#pragma unroll
        for (int j = 0; j < 4; ++j) { w[j] = ((const f32x4*)nw)[64 * j + C.lane]; sc[j] = ((const f32x4*)(mod + b * 6144 + sc_off))[64 * j + C.lane] + 1.0f; sh[j] = ((const f32x4*)(mod + b * 6144 + sh_off))[64 * j + C.lane]; }
        float ss[8];
#pragma unroll
        for (int q = 0; q < 8; ++q) { float a = 0.f;
#pragma unroll
            for (int j = 0; j < 4; ++j) a += (v[q][j].x * v[q][j].x + v[q][j].y * v[q][j].y) + (v[q][j].z * v[q][j].z + v[q][j].w * v[q][j].w);
            ss[q] = a; }
#pragma unroll
        for (int o = 1; o < 64; o <<= 1) {
#pragma unroll
            for (int q = 0; q < 8; ++q) ss[q] += __shfl_xor(ss[q], o); }
#pragma unroll
        for (int q = 0; q < 8; ++q) { const float rstd = rsqrtf(ss[q] * (1.f / DM) + 1e-6f);
            u32x2* o8 = (u32x2*)(dst + (size_t)(m0 + q) * DM) + C.lane;
#pragma unroll
            for (int j = 0; j < 4; ++j) { const f32x4 y = v[q][j] * rstd * w[j] * sc[j] + sh[j]; o8[64 * j] = (u32x2){pk2(y.x, y.y), pk2(y.z, y.w)}; } }
        if (C.tid == 0) qw[(n + 1) & 1] = nq_;
        __syncthreads();
    }
}

__device__ __forceinline__ float gelu_tanh(float x) { const float u = 0.7978845608028654f * (x + 0.044715f * x * x * x); const float e = __expf(2.f * u); return 0.5f * x * (1.f + (1.f - 2.f / (e + 1.f))); }
__device__ __forceinline__ void compress_phase(const Ctx& C) {
    const int lane = C.lane, wid = C.wave, fr = lane & 15, kq = lane >> 4;
    LAS bf16_t* H = (LAS bf16_t*)C.lds;
    LAS float* nrm = (LAS float*)(C.lds + 12288);
    for (int u = C.bid; u < 256; u += C.G) {
        const int kv = u >> 7, b = (u >> 5) & 3, g = (u >> 4) & 1, c0 = (u & 15) * 32;
        const bf16_t* P = (const bf16_t*)(C.ws + WS_PROJ) + (size_t)b * SEQ * PROJ_W + (kv ? C_CV : C_CK) + g * 64;
        const float* pe = C.gin(kv ? 14 : 11);
        LAS unsigned char* AT = C.lds + 24576; LAS float* PE = (LAS float*)(C.lds + 16384);
        __syncthreads();
        for (int i = C.tid; i < 528 * 8; i += NTHREADS) { const int row = i >> 3, ch = i & 7; int tok = 16 * c0 + row; tok = tok < SEQ ? tok : SEQ - 1;
            *(LAS u32x4*)(AT + row * 128 + ((ch ^ ((row >> 4) & 7)) << 4)) = *(const u32x4*)(P + (size_t)tok * PROJ_W + ch * 8); }
        ((LAS f32x4*)PE)[C.tid] = ((const f32x4*)pe)[C.tid];
        __syncthreads();
        const u32x4* w1f = (const u32x4*)(C.ws + (kv ? WS_CVW1 : WS_CKW1)) + (size_t)wid * 64 * 64 + lane;
        f32x4 acc[2] = {(f32x4){0.f, 0.f, 0.f, 0.f}, (f32x4){0.f, 0.f, 0.f, 0.f}};
#pragma unroll 1
        for (int k8 = 0; k8 < 64; k8 += 8) {
        u32x4 bq[8];
#pragma unroll
        for (int j = 0; j < 8; ++j) bq[j] = w1f[(k8 + j) * 64];
#pragma unroll
        for (int j = 0; j < 8; ++j) { const int ks = k8 + j;
            const int l = ks >> 1, hf = ks & 1;
            const bf16x8 bfrag = __builtin_bit_cast(bf16x8, bq[j]);
            const f32x4 p0 = *(const LAS f32x4*)(PE + l * 64 + 32 * hf + 8 * kq), p1 = *(const LAS f32x4*)(PE + l * 64 + 32 * hf + 8 * kq + 4);
            const int sw = (((4 * hf + kq) ^ ((fr + (l >> 4)) & 7)) << 4);
#pragma unroll
            for (int mt = 0; mt < 2; ++mt) {
                const u32x4 xv = *(const LAS u32x4*)(AT + (256 * mt + 16 * fr + l) * 128 + sw);
                u32x4 av; av.x = pk2(bflo(xv.x) + p0[0], bfhi(xv.x) + p0[1]); av.y = pk2(bflo(xv.y) + p0[2], bfhi(xv.y) + p0[3]);
                av.z = pk2(bflo(xv.z) + p1[0], bfhi(xv.z) + p1[1]); av.w = pk2(bflo(xv.w) + p1[2], bfhi(xv.w) + p1[3]);
                acc[mt] = __builtin_amdgcn_mfma_f32_16x16x32_bf16(__builtin_bit_cast(bf16x8, av), bfrag, acc[mt], 0, 0, 0);
            }
        }
        }
#pragma unroll
        for (int mt = 0; mt < 2; ++mt)
#pragma unroll
            for (int i = 0; i < 4; ++i) H[(16 * mt + 4 * kq + i) * 136 + 16 * wid + fr] = (bf16_t)f2bf(gelu_tanh(acc[mt][i]));
        __syncthreads();
        if (wid < 4) {
            const bf16_t* w2 = (const bf16_t*)(C.ws + (kv ? WS_CVW2 : WS_CKW2)) + (size_t)(16 * wid + fr) * 128;
            f32x4 o[2] = {(f32x4){0.f, 0.f, 0.f, 0.f}, (f32x4){0.f, 0.f, 0.f, 0.f}};
#pragma unroll
            for (int ks = 0; ks < 4; ++ks) { const bf16x8 bfrag = *(const bf16x8*)(w2 + 32 * ks + 8 * kq);
#pragma unroll
                for (int mt = 0; mt < 2; ++mt) { const bf16x8 afrag = *(const LAS bf16x8*)(H + (16 * mt + fr) * 136 + 32 * ks + 8 * kq);
                    o[mt] = __builtin_amdgcn_mfma_f32_16x16x32_bf16(afrag, bfrag, o[mt], 0, 0, 0); } }
            bf16_t* dst = (bf16_t*)(C.ws + (kv ? WS_VC : WS_KC)) + (size_t)(b * 2 + g) * 512 * 64;
#pragma unroll
            for (int mt = 0; mt < 2; ++mt)
#pragma unroll
                for (int i = 0; i < 4; ++i) { const int c = c0 + 16 * mt + 4 * kq + i; const unsigned hb = c < 511 ? f2bf(o[mt][i]) : 0u; dst[(size_t)c * 64 + 16 * wid + fr] = (bf16_t)hb;
                    float pq = bf2f((unsigned short)hb); pq *= pq; pq += __shfl_xor(pq, 1); pq += __shfl_xor(pq, 2); pq += __shfl_xor(pq, 4); pq += __shfl_xor(pq, 8);
                    if (fr == 0) nrm[(16 * mt + 4 * kq + i) * 4 + wid] = pq; }
        }
        __syncthreads();
        if (kv == 0 && C.tid < 32) { float v = sqrtf(nrm[C.tid * 4] + nrm[C.tid * 4 + 1] + nrm[C.tid * 4 + 2] + nrm[C.tid * 4 + 3]) * 1.001f;
#pragma unroll
            for (int o2 = 1; o2 < 32; o2 <<= 1) v = fmaxf(v, __shfl_xor(v, o2));
            if (C.tid == 0) atomicMax((unsigned*)(C.ws + WS_CTL) + CW_KCMAX + b * 2 + g, __float_as_uint(v)); }
    }
}

__device__ __forceinline__ void knorm_phase(const Ctx& C) {
    LAS float* red = (LAS float*)(C.lds + 16384);
    LAS float* red2 = (LAS float*)(C.lds + 16384 + 8192);
    for (int it = C.bid; it < 512; it += C.G) {
        const int b = it >> 7, t = it & 127, tok = C.tid >> 3, part = C.tid & 7;
        const u32x4* src = (const u32x4*)((const bf16_t*)(C.ws + WS_PROJ) + (size_t)(b * SEQ + 64 * t + tok) * PROJ_W + C_DAK + part * 128);
        float ss[2] = {0.f, 0.f};
#pragma unroll
        for (int cc = 0; cc < 2; ++cc)
#pragma unroll
            for (int i = 0; i < 8; ++i) { const u32x4 w = src[cc * 8 + i];
                ss[cc] += bflo(w.x) * bflo(w.x) + bfhi(w.x) * bfhi(w.x) + bflo(w.y) * bflo(w.y) + bfhi(w.y) * bfhi(w.y) + bflo(w.z) * bflo(w.z) + bfhi(w.z) * bfhi(w.z) + bflo(w.w) * bflo(w.w) + bfhi(w.w) * bfhi(w.w); }
        red[tok * 17 + part * 2] = ss[0]; red[tok * 17 + part * 2 + 1] = ss[1];
        if (part < 2) {
            const u32x4* sk = (const u32x4*)((const bf16_t*)(C.ws + WS_PROJ) + (size_t)(b * SEQ + 64 * t + tok) * PROJ_W + C_SK + part * 64); float sq = 0.f;
#pragma unroll
            for (int i = 0; i < 8; ++i) { const u32x4 w = sk[i];
                sq += bflo(w.x) * bflo(w.x) + bfhi(w.x) * bfhi(w.x) + bflo(w.y) * bflo(w.y) + bfhi(w.y) * bfhi(w.y) + bflo(w.z) * bflo(w.z) + bfhi(w.z) * bfhi(w.z) + bflo(w.w) * bflo(w.w) + bfhi(w.w) * bfhi(w.w); }
            red2[tok * 2 + part] = sq; }
        __syncthreads();
        if (C.tid >= 64 && C.tid < 128) { const int l2 = C.tid - 64, gcol = l2 & 1; float mx = fmaxf(red2[(l2 >> 1) * 2 + gcol], red2[(32 + (l2 >> 1)) * 2 + gcol]);
#pragma unroll
            for (int o2 = 2; o2 < 64; o2 <<= 1) mx = fmaxf(mx, __shfl_xor(mx, o2));
            if (l2 < 2) ((float*)(C.ws + WS_KSN))[((size_t)b * 2 + gcol) * 128 + t] = sqrtf(mx) * 1.001f; }
        if (C.tid < 64) { const int col = C.tid & 15, q4 = C.tid >> 4; float mx = 0.f;
#pragma unroll
            for (int k = 0; k < 16; ++k) mx = fmaxf(mx, red[(q4 * 16 + k) * 17 + col]);
            mx = fmaxf(mx, __shfl_xor(mx, 16)); mx = fmaxf(mx, __shfl_xor(mx, 32));
            if (C.tid < 16) ((float*)(C.ws + WS_KTN))[((size_t)b * 16 + C.tid) * 128 + t] = sqrtf(mx) * 1.001f; }
        __syncthreads();
    }
}

constexpr int DA_KB = 16384, DA_VSTR = 320, DA_VB = 64 * DA_VSTR;
constexpr int DA_LDS_K = 0, DA_LDS_V = 2 * DA_KB, DA_LDS_OS = DA_LDS_V + 2 * DA_VB;
constexpr int DA_LDS_KPM = DA_LDS_OS + 32768;
constexpr int DA_LDS_FLG = DA_LDS_KPM + 2048;
constexpr int ATT_LDS_Q = DA_LDS_FLG + 64;
constexpr int ATT_LDS_SW = 143360;
__device__ __forceinline__ unsigned cvtpk(float lo, float hi) { return pk2(lo, hi); }
__device__ __forceinline__ bf16x8 pack8c(const f32x16& p, int b) { u32x4 w; w.x = cvtpk(p[b], p[b + 1]); w.y = cvtpk(p[b + 2], p[b + 3]); w.z = cvtpk(p[b + 4], p[b + 5]); w.w = cvtpk(p[b + 6], p[b + 7]); return __builtin_bit_cast(bf16x8, w); }
__device__ __forceinline__ void da_unit(const Ctx& C, int b, int h, int qb, float lam) {
    const int tid = C.tid, lane = C.lane, wid = C.wave, r32 = lane & 31, hi = lane >> 5, c = wid >> 2, wq = wid & 3;
    const bf16_t* P = (const bf16_t*)(C.ws + WS_PROJ) + (size_t)b * SEQ * PROJ_W;
    const int q0w = qb * 128 + wq * 32, tq = q0w + r32;
    const float slope2 = exp2f(-(float)(2 * h + 1) * 0.5f) * LOG2E;
    const float DA_THR = 25.5f - log2f(slope2 * 0.6931472f);
    const int NT = 2 * qb + 2, tmaxw = 2 * qb + (wq >> 1);
    LAS unsigned char* lds = C.lds;
    LAS unsigned* osv = (LAS unsigned*)(lds + DA_LDS_OS) + wq * 2048 + lane;
    LAS float* kraw = (LAS float*)(lds + DA_LDS_KPM); LAS float* kpm = kraw + 256; LAS int* flg = (LAS int*)(lds + DA_LDS_FLG);
    if (wid < 4) {
        const float* src = (const float*)(C.ws + WS_KTN) + ((size_t)(b * 8 + h) * 2 + (wid >> 1)) * 128;
        float v = src[(wid & 1) * 64 + lane];
#pragma unroll
        for (int o = 1; o < 64; o <<= 1) { const float u = __shfl_up(v, o); if (lane >= o) v = fmaxf(v, u); }
        if (wid & 1) { float t0 = src[lane];
#pragma unroll
            for (int o = 1; o < 64; o <<= 1) t0 = fmaxf(t0, __shfl_xor(t0, o));
            v = fmaxf(v, t0); }
        kpm[(wid >> 1) * 128 + (wid & 1) * 64 + lane] = v;
    }
    const int skey = tid >> 4, sch = tid & 15;
    const int kdst0 = (sch >> 3) * 8192 + skey * 128 + (((sch & 7) ^ ((skey >> 1) & 7)) << 4), kdst1 = kdst0 + 32 * 128;
    const int vdst0 = skey * DA_VSTR + sch * 16, vdst1 = vdst0 + 32 * DA_VSTR;
    const int vrd = (4 * hi + ((lane & 15) >> 2)) * DA_VSTR + (16 * ((lane >> 4) & 1) + 4 * (lane & 3)) * 2;
    bf16x8 qf[4];
#pragma unroll
    for (int d0 = 0; d0 < 4; ++d0) qf[d0] = *(const bf16x8*)(P + (size_t)tq * PROJ_W + C_DAQ + h * 128 + c * 64 + d0 * 16 + hi * 8);
    float qn;
    { float ss = 0.f;
#pragma unroll
      for (int d0 = 0; d0 < 4; ++d0) { const u32x4 w = __builtin_bit_cast(u32x4, qf[d0]);
          ss += bflo(w.x) * bflo(w.x) + bfhi(w.x) * bfhi(w.x) + bflo(w.y) * bflo(w.y) + bfhi(w.y) * bfhi(w.y) + bflo(w.z) * bflo(w.z) + bfhi(w.z) * bfhi(w.z) + bflo(w.w) * bflo(w.w) + bfhi(w.w) * bfhi(w.w); }
      qn = sqrtf(swap32_sum(ss)) * 1.001f; }
    f32x16 o[4];
#pragma unroll
    for (int d = 0; d < 4; ++d)
#pragma unroll
        for (int r = 0; r < 16; ++r) o[d][r] = 0.f;
    float m = 0.f, l = 0.f; bool first = true;
    const bf16_t* ksrc = P + (size_t)skey * PROJ_W + C_DAK + h * 128 + sch * 8;
    const bf16_t* vsrc = P + (size_t)skey * PROJ_W + C_DAV + h * 128 + sch * 8;
    u32x4 kreg0, kreg1, vreg0, vreg1;
    { const size_t adv = (size_t)(NT - 1) * 64 * PROJ_W; kreg0 = *(const u32x4*)(ksrc + adv); kreg1 = *(const u32x4*)(ksrc + adv + (size_t)32 * PROJ_W); vreg0 = *(const u32x4*)(vsrc + adv); vreg1 = *(const u32x4*)(vsrc + adv + (size_t)32 * PROJ_W); }
    *(LAS u32x4*)(lds + DA_LDS_K + kdst0) = kreg0; *(LAS u32x4*)(lds + DA_LDS_K + kdst1) = kreg1; *(LAS u32x4*)(lds + DA_LDS_V + vdst0) = vreg0; *(LAS u32x4*)(lds + DA_LDS_V + vdst1) = vreg1;
    __syncthreads();
    bool done = false;
    int t = NT - 1;
#pragma unroll 1
    for (int it = 0;; ++it, --t) {
        const int buf = it & 1;
        if (t > 0) { const size_t adv = (size_t)(t - 1) * 64 * PROJ_W; kreg0 = *(const u32x4*)(ksrc + adv); kreg1 = *(const u32x4*)(ksrc + adv + (size_t)32 * PROJ_W); vreg0 = *(const u32x4*)(vsrc + adv); vreg1 = *(const u32x4*)(vsrc + adv + (size_t)32 * PROJ_W); }
        if (t <= tmaxw && !done) {
            LAS const unsigned char* kb = lds + DA_LDS_K + buf * DA_KB + c * 8192; LAS const unsigned char* vb = lds + DA_LDS_V + buf * DA_VB;
            const float sd = slope2 * (float)(64 * t + 4 * hi - tq) - m;
            f32x16 s0, s1;
#pragma unroll
            for (int r = 0; r < 16; ++r) { s0[r] = fmaf(slope2, (float)CR(r), sd); s1[r] = fmaf(slope2, (float)(32 + CR(r)), sd); }
#pragma unroll
            for (int d0 = 0; d0 < 4; ++d0) { const int sw = ((2 * d0 + hi) ^ ((r32 >> 1) & 7)) << 4;
                const bf16x8 k0 = *(const LAS bf16x8*)(kb + r32 * 128 + sw), k1 = *(const LAS bf16x8*)(kb + (32 + r32) * 128 + sw);
                s0 = __builtin_amdgcn_mfma_f32_32x32x16_bf16(k0, qf[d0], s0, 0, 0, 0); s1 = __builtin_amdgcn_mfma_f32_32x32x16_bf16(k1, qf[d0], s1, 0, 0, 0); }
            if (t == tmaxw) { const int lim = tq - 64 * t - 4 * hi;
#pragma unroll
                for (int r = 0; r < 16; ++r) { if (CR(r) > lim) s0[r] = NEG_INF; if (32 + CR(r) > lim) s1[r] = NEG_INF; } }
            float mx = fmaxf(s0[0], s1[0]);
#pragma unroll
            for (int r = 1; r < 16; ++r) mx = fmaxf(mx, fmaxf(s0[r], s1[r]));
            mx = swap32_max(mx);
            const float dl = first ? mx : fmaxf(mx, 0.f);
            if (__any(dl != 0.f)) {
                const float alpha = first ? 1.0f : fast_exp2(-dl); m += dl; l *= alpha;
#pragma unroll
                for (int r = 0; r < 16; ++r) { s0[r] -= dl; s1[r] -= dl; }
                if (!first) {
#pragma unroll
                    for (int d = 0; d < 4; ++d)
#pragma unroll
                        for (int r = 0; r < 16; ++r) o[d][r] *= alpha; }
            }
            first = false;
            float sum = 0.f;
#pragma unroll
            for (int r = 0; r < 16; ++r) { s0[r] = fast_exp2(s0[r]); s1[r] = fast_exp2(s1[r]); sum += s0[r] + s1[r]; }
            l += sum;
            bf16x8 pk[4]; pk[0] = pack8c(s0, 0); pk[1] = pack8c(s0, 8); pk[2] = pack8c(s1, 0); pk[3] = pack8c(s1, 8);
#pragma unroll
            for (int ks = 0; ks < 4; ++ks)
#pragma unroll
                for (int db = 0; db < 4; ++db) { LAS const unsigned char* a = vb + vrd + ks * 16 * DA_VSTR + db * 64;
                    const s16x4 lo = tr_read(a), hi4 = tr_read(a + 8 * DA_VSTR);
                    const bf16x8 vf = (bf16x8){lo[0], lo[1], lo[2], lo[3], hi4[0], hi4[1], hi4[2], hi4[3]};
                    o[db] = __builtin_amdgcn_mfma_f32_32x32x16_bf16(vf, pk[ks], o[db], 0, 0, 0); }
            if (t > 0) { const float bound = qn * kpm[c * 128 + t - 1] + 0.01f - slope2 * (float)(tq - 64 * t + 1); done = __all(bound < m - DA_THR) != 0; }
        }
        if (t > 0) { const int nb = (buf ^ 1) * DA_KB, nv = (buf ^ 1) * DA_VB; *(LAS u32x4*)(lds + DA_LDS_K + nb + kdst0) = kreg0; *(LAS u32x4*)(lds + DA_LDS_K + nb + kdst1) = kreg1;
            *(LAS u32x4*)(lds + DA_LDS_V + nv + vdst0) = vreg0; *(LAS u32x4*)(lds + DA_LDS_V + nv + vdst1) = vreg1; }
        if (lane == 0) flg[buf * 8 + wid] = done ? 1 : 0;
        __syncthreads();
        if (t == 0) break;
        { const LAS int* f = flg + buf * 8; const int all = f[0] & f[1] & f[2] & f[3] & f[4] & f[5] & f[6] & f[7]; if (all) break; }
    }
    l = swap32_sum(l); const float inv = 1.0f / l;
    if (c == 0) {
#pragma unroll
        for (int d = 0; d < 4; ++d)
#pragma unroll
            for (int r = 0; r < 16; r += 2) osv[(d * 8 + (r >> 1)) * 64] = cvtpk(o[d][r] * inv, o[d][r + 1] * inv);
    }
    __syncthreads();
    if (c == 1) {
        float ssq = 0.f;
#pragma unroll
        for (int d = 0; d < 4; ++d)
#pragma unroll
            for (int r = 0; r < 16; r += 2) { const unsigned sv = osv[(d * 8 + (r >> 1)) * 64];
                const float v0 = bflo(sv) - lam * (o[d][r] * inv), v1 = bfhi(sv) - lam * (o[d][r + 1] * inv); o[d][r] = v0; o[d][r + 1] = v1; ssq += v0 * v0 + v1 * v1; }
        ssq = swap32_sum(ssq);
        const float rstd = rsqrtf(ssq * (1.0f / 128.0f) + 1e-5f) * 0.8f;
        LAS const float* sw = (LAS const float*)(C.lds + ATT_LDS_SW);
        bf16_t* orow = (bf16_t*)(C.ws + WS_XN) + (size_t)(b * SEQ + tq) * DM + h * 128;
#pragma unroll
        for (int d = 0; d < 4; ++d)
#pragma unroll
            for (int p = 0; p < 2; ++p) { unsigned pk_[2][2];
#pragma unroll
                for (int q = 0; q < 2; ++q) { const int g4 = 2 * p + q, dd = 32 * d + 8 * g4 + 4 * hi; const f32x4 w = *(LAS const f32x4*)(sw + dd);
                    pk_[q][0] = cvtpk(o[d][4 * g4] * rstd * w[0], o[d][4 * g4 + 1] * rstd * w[1]); pk_[q][1] = cvtpk(o[d][4 * g4 + 2] * rstd * w[2], o[d][4 * g4 + 3] * rstd * w[3]); }
                *(u32x4*)(orow + 32 * d + 8 * (2 * p + hi)) = pair_swap_store(pk_[0][0], pk_[0][1], pk_[1][0], pk_[1][1]); }
    }
}

constexpr int NSA_WLDS = 8192 + 4096 + 256;
struct NsaState { float m, l; f32x16 o[2]; };
struct NsaTile { bf16x8 kf[2][4]; };
struct NsaSrc { __amdgpu_buffer_rsrc_t rk, rv; unsigned kvo, vvo; int pitchB; };
__device__ __forceinline__ NsaSrc nsa_src(const bf16_t* kbase, const bf16_t* vbase, int pitch, int lane) {
    NsaSrc S; S.rk = __builtin_amdgcn_make_buffer_rsrc((void*)kbase, 0, 0x7fffffff, 0x00020000); S.rv = __builtin_amdgcn_make_buffer_rsrc((void*)vbase, 0, 0x7fffffff, 0x00020000);
    S.kvo = (unsigned)((lane & 31) * pitch + 8 * (lane >> 5)) * 2u; S.vvo = (unsigned)((lane >> 3) * pitch + (lane & 7) * 8) * 2u; S.pitchB = pitch * 2; return S;
}
__device__ __forceinline__ void nsa_issue_k(NsaTile& T, const NsaSrc& S, int row0) {
#pragma unroll
    for (int blk = 0; blk < 2; ++blk) { const int so = __builtin_amdgcn_readfirstlane((row0 + 32 * blk) * S.pitchB);
#pragma unroll
        for (int d0 = 0; d0 < 4; ++d0) T.kf[blk][d0] = __builtin_bit_cast(bf16x8, __builtin_amdgcn_raw_buffer_load_b128(S.rk, S.kvo + 32 * d0, so, 0)); }
}
template <int MODE>
__device__ __forceinline__ void nsa_step(NsaState& st, NsaTile& T, const bf16x8 (&qf)[4], const NsaSrc& S, int row0,
                                         int pos0, int pstride, int tq, float slope2, bool rowsel, LAS unsigned char* vt, LAS float* imp, int tile, float invl, int lane,
                                         bool has_next, int nrow0) {
    const int r32 = lane & 31, hi = lane >> 5;
    u32x4 vr[8];
    if (MODE != 0) {
#pragma unroll
        for (int it = 0; it < 8; ++it) vr[it] = __builtin_bit_cast(u32x4, __builtin_amdgcn_raw_buffer_load_b128(S.rv, S.vvo, __builtin_amdgcn_readfirstlane((row0 + 8 * it) * S.pitchB), 0)); }
    asm volatile("" ::: "memory");
    const float ps = (float)pstride;
    const bool unset = st.m < -1e29f; const float ref = unset ? 0.f : st.m;
    float sd = slope2 * (float)(pos0 + pstride * 4 * hi - tq) - ref;
    if (MODE == 2) sd = rowsel ? sd : NEG_INF;
    f32x16 s[2];
#pragma unroll
    for (int blk = 0; blk < 2; ++blk)
#pragma unroll
        for (int r = 0; r < 16; ++r) s[blk][r] = fmaf(slope2 * ps, (float)(32 * blk + CR(r)), sd);
#pragma unroll
    for (int blk = 0; blk < 2; ++blk)
#pragma unroll
        for (int d0 = 0; d0 < 4; ++d0) s[blk] = __builtin_amdgcn_mfma_f32_32x32x16_bf16(T.kf[blk][d0], qf[d0], s[blk], 0, 0, 0);
    if (has_next) nsa_issue_k(T, S, nrow0);
    const int tw0_ = __builtin_amdgcn_readfirstlane(tq - (r32 & 7));
    const bool needmask = (pos0 + pstride * 63 > tw0_) || (MODE == 3 && pos0 <= tw0_ + 7 - 512);
    if (needmask) {
        const int lim = tq - pos0 - pstride * 4 * hi;
#pragma unroll
        for (int blk = 0; blk < 2; ++blk)
#pragma unroll
            for (int r = 0; r < 16; ++r) { const int off = pstride * (32 * blk + CR(r)); bool ok = off <= lim;
                if (MODE == 3) ok = ok && (off > lim - 512);
                if (!ok) s[blk][r] = NEG_INF; }
    }
    if (MODE == 0 || MODE == 2 || MODE == 3) {
        float mx = fmaxf(s[0][0], s[1][0]);
#pragma unroll
        for (int r = 1; r < 16; ++r) mx = fmaxf(mx, fmaxf(s[0][r], s[1][r]));
        mx = swap32_max(mx);
        const bool none = !(mx > NEG_INF);
        const float dl = none ? 0.f : (unset ? mx : fmaxf(mx, 0.f));
        if (!(none && unset)) st.m = ref + dl;
        if (__any(dl != 0.f)) {
            const float alpha = unset ? 1.0f : fast_exp2(-dl); st.l *= alpha;
#pragma unroll
            for (int blk = 0; blk < 2; ++blk)
#pragma unroll
                for (int r = 0; r < 16; ++r) s[blk][r] -= dl;
            if (MODE != 0) {
#pragma unroll
                for (int d = 0; d < 2; ++d)
#pragma unroll
                    for (int r = 0; r < 16; ++r) st.o[d][r] *= alpha; }
        }
        float sum = 0.f;
#pragma unroll
        for (int blk = 0; blk < 2; ++blk)
#pragma unroll
            for (int r = 0; r < 16; ++r) { s[blk][r] = fast_exp2(s[blk][r]); sum += s[blk][r]; }
        st.l += sum;
    } else {
#pragma unroll
        for (int blk = 0; blk < 2; ++blk)
#pragma unroll
            for (int r = 0; r < 16; ++r) s[blk][r] = fast_exp2(s[blk][r]) * invl;
        const int tokl = r32 & 7;
#pragma unroll
        for (int blk = 0; blk < 2; ++blk)
#pragma unroll
            for (int g4 = 0; g4 < 4; ++g4) { float cy = 0.5f * s[blk][4 * g4 + 3]; float uu = s[blk][4 * g4] + s[blk][4 * g4 + 1] + s[blk][4 * g4 + 2] + cy;
                uu += dpp_f<DPP_ROR8>(uu); uu += __shfl_xor(uu, 16); cy += dpp_f<DPP_ROR8>(cy); cy += __shfl_xor(cy, 16);
                const int n = 16 * tile + 8 * blk + 2 * g4 + hi;
                if (r32 < 8) { LAS float* ip = imp + tokl * 128 + n; ip[0] = ip[0] + uu; }
                asm volatile("" ::: "memory");
                if (r32 < 8 && n + 1 < 128) { LAS float* ip = imp + tokl * 128 + n + 1; ip[0] = ip[0] + cy; }
                asm volatile("" ::: "memory"); }
    }
    if (MODE != 0) {
#pragma unroll
        for (int it = 0; it < 8; ++it) { const int key = it * 8 + (lane >> 3), ch = lane & 7; *(LAS u32x4*)(vt + (ch >> 2) * 4096 + key * 64 + (ch & 3) * 16) = vr[it]; }
        bf16x8 pk[4]; pk[0] = pack8c(s[0], 0); pk[1] = pack8c(s[0], 8); pk[2] = pack8c(s[1], 0); pk[3] = pack8c(s[1], 8);
        const int vrd = (4 * hi + ((lane & 15) >> 2)) * 64 + (16 * ((lane >> 4) & 1) + 4 * (lane & 3)) * 2;
#pragma unroll
        for (int ks = 0; ks < 4; ++ks)
#pragma unroll
            for (int db = 0; db < 2; ++db) { LAS const unsigned char* a = vt + db * 4096 + vrd + ks * 16 * 64;
                const s16x4 lo = tr_read(a), hi4 = tr_read(a + 8 * 64);
                const bf16x8 vf = (bf16x8){lo[0], lo[1], lo[2], lo[3], hi4[0], hi4[1], hi4[2], hi4[3]};
                st.o[db] = __builtin_amdgcn_mfma_f32_32x32x16_bf16(vf, pk[ks], st.o[db], 0, 0, 0); }
    }
}
__device__ __forceinline__ void nsa_reset(NsaState& st) { st.m = -1e30f; st.l = 0.f;
#pragma unroll
    for (int d = 0; d < 2; ++d)
#pragma unroll
        for (int r = 0; r < 16; ++r) st.o[d][r] = 0.f; }
__device__ __forceinline__ int next_bit128(unsigned long long lo, unsigned long long hi, int after) {
    if (after < 63) { const unsigned long long mm = lo & (~0ull << (after + 1)); if (mm) return __builtin_ctzll(mm); }
    const int a2 = after < 63 ? -1 : after - 64;
    const unsigned long long m2 = (a2 < 63) ? (hi & (~0ull << (a2 + 1))) : 0ull;
    return m2 ? 64 + __builtin_ctzll(m2) : -1;
}

__device__ __forceinline__ int prev_bit128(unsigned long long lo, unsigned long long hi, int before) {
    if (before > 64) { const unsigned long long mm = before >= 128 ? hi : (hi & ((1ull << (before - 64)) - 1ull)); if (mm) return 127 - __builtin_clzll(mm); }
    const int b2 = before > 64 ? 64 : before;
    const unsigned long long m2 = b2 >= 64 ? lo : (b2 <= 0 ? 0ull : (lo & ((1ull << b2) - 1ull)));
    return m2 ? 63 - __builtin_clzll(m2) : -1;
}
constexpr float NSA_THR = 36.0f;
__device__ __forceinline__ void nsa_unit(const Ctx& C, int b, int g, int T0) {
    const int lane = C.lane, wid = C.wave, r32 = lane & 31, hi = lane >> 5;
    const int tokl = r32 & 7, head = r32 >> 3, hq = g * 4 + head, tw0 = T0 + 8 * wid, tq = tw0 + tokl;
    const float slope2 = exp2f(-(float)(hq + 1)) * LOG2E;
    const bf16_t* P = (const bf16_t*)(C.ws + WS_PROJ) + (size_t)b * SEQ * PROJ_W;
    LAS unsigned char* vt = C.lds + wid * NSA_WLDS; LAS float* imp = (LAS float*)(vt + 8192); LAS unsigned* selm = (LAS unsigned*)(vt + 8192 + 4096);
    bf16x8 qf[4];
#pragma unroll
    for (int d0 = 0; d0 < 4; ++d0) qf[d0] = *(const bf16x8*)(P + (size_t)tq * PROJ_W + C_NQ + hq * 64 + d0 * 16 + hi * 8);
    const float* gates = (const float*)(C.ws + WS_NSAG) + (size_t)(b * SEQ + tq) * 24 + hq * 3;
    float qn;
    { float ss = 0.f;
#pragma unroll
      for (int d0 = 0; d0 < 4; ++d0) { const u32x4 w = __builtin_bit_cast(u32x4, qf[d0]);
          ss += bflo(w.x) * bflo(w.x) + bfhi(w.x) * bfhi(w.x) + bflo(w.y) * bflo(w.y) + bfhi(w.y) * bfhi(w.y) + bflo(w.z) * bflo(w.z) + bfhi(w.z) * bfhi(w.z) + bflo(w.w) * bflo(w.w) + bfhi(w.w) * bfhi(w.w); }
      qn = sqrtf(swap32_sum(ss)) * 1.001f; }
    const float kcmax = __uint_as_float(((const unsigned*)(C.ws + WS_CTL))[CW_KCMAX + b * 2 + g]);
    const float ksn_lo = ((const float*)(C.ws + WS_KSN))[(size_t)(b * 2 + g) * 128 + lane], ksn_hi = ((const float*)(C.ws + WS_KSN))[(size_t)(b * 2 + g) * 128 + 64 + lane];
    NsaState st; NsaTile T;
    LAS unsigned* accl = (LAS unsigned*)imp + lane;
    const bf16_t* kc = (const bf16_t*)(C.ws + WS_KC) + (size_t)(b * 2 + g) * 512 * 64; const bf16_t* vc = (const bf16_t*)(C.ws + WS_VC) + (size_t)(b * 2 + g) * 512 * 64;
    const int ncmp = (tw0 + 7 >= 31) ? ((tw0 + 7 - 31) >> 4) + 1 : 0, nct = (ncmp + 63) >> 6;
    nsa_reset(st);
    int ln = lane; asm volatile("" : "+v"(ln));
    int tstop = 0;
    const NsaSrc Sc = nsa_src(kc, vc, 64, ln);
    if (nct > 0) nsa_issue_k(T, Sc, 64 * (nct - 1));
    for (int t = nct - 1; t >= 0; --t) {
        bool more = t > 0;
        if (more) { const float bound = qn * kcmax + 0.01f - slope2 * (float)(tq - (16 * (64 * t - 1) + 31)); more = !(__all(bound < st.m - NSA_THR) != 0); }
        nsa_step<0>(st, T, qf, Sc, 64 * t, 16 * 64 * t + 31, 16, tq, slope2, true, vt, imp, t, 0.f, ln, more, 64 * (t - 1));
        if (!more) { tstop = t; break; }
    }
    {
        const float lt = swap32_sum(st.l); const float invl = lt > 0.f ? 1.0f / lt : 0.f;
        for (int i = lane; i < 1024; i += 64) imp[i] = 0.f;
        asm volatile("" : "+v"(ln));
        if (nct > 0) nsa_issue_k(T, Sc, 64 * tstop);
        for (int t = tstop; t < nct; ++t) nsa_step<1>(st, T, qf, Sc, 64 * t, 16 * 64 * t + 31, 16, tq, slope2, true, vt, imp, t, invl, ln, t + 1 < nct, 64 * (t + 1));
    }
    { const float gc = gates[0]; LAS float* park = (LAS float*)vt + lane;
#pragma unroll
      for (int d = 0; d < 2; ++d)
#pragma unroll
          for (int r = 0; r < 16; ++r) park[(d * 16 + r) * 64] = st.o[d][r] * gc; }
    {
        const int tokS = lane >> 3, j = lane & 7, tS = tw0 + tokS, cur = tS >> 6;
        float v[16];
#pragma unroll
        for (int i = 0; i < 16; ++i) { const int n = 16 * j + i; const float val = imp[tokS * 128 + n]; const bool causal = n <= cur, forced = (n == 0) || (n == cur) || (n == cur - 1);
            v[i] = causal ? val + (forced ? 1e4f : 0.f) : NEG_INF; }
        unsigned mk0 = 0u, mk1 = 0u, mk2 = 0u, mk3 = 0u;
#pragma unroll 1
        for (int it = 0; it < 16; ++it) {
            float bv = v[0]; int bi = 0;
#pragma unroll
            for (int i = 1; i < 16; ++i) if (v[i] > bv) { bv = v[i]; bi = i; }
            int bn = 16 * j + bi;
#define SEL_STEP(CTRL) { const float ov = dpp_f<CTRL>(bv); const int on = dpp_i<CTRL>(bn); if (ov > bv || (ov == bv && on < bn)) { bv = ov; bn = on; } }
            SEL_STEP(DPP_XOR1) SEL_STEP(DPP_XOR2) SEL_STEP(DPP_HMIRROR)
#undef SEL_STEP
            if (bv > NEG_INF) { const unsigned bit = 1u << (bn & 31); const int w = bn >> 5;
                mk0 |= (w == 0) ? bit : 0u; mk1 |= (w == 1) ? bit : 0u; mk2 |= (w == 2) ? bit : 0u; mk3 |= (w == 3) ? bit : 0u;
#pragma unroll
                for (int i = 0; i < 16; ++i) if (16 * j + i == bn) v[i] = NEG_INF; }
        }
        if (j == 0) { selm[tokS * 4 + 0] = mk0; selm[tokS * 4 + 1] = mk1; selm[tokS * 4 + 2] = mk2; selm[tokS * 4 + 3] = mk3; }
        unsigned U[4] = {mk0, mk1, mk2, mk3};
#pragma unroll
        for (int w = 0; w < 4; ++w) { U[w] |= __shfl_xor(U[w], 8); U[w] |= __shfl_xor(U[w], 16); U[w] |= __shfl_xor(U[w], 32); U[w] = __builtin_amdgcn_readfirstlane(U[w]); }
        const unsigned long long ulo = (unsigned long long)U[0] | ((unsigned long long)U[1] << 32), uhi = (unsigned long long)U[2] | ((unsigned long long)U[3] << 32);
        { LAS const float* park = (LAS const float*)vt + lane;
#pragma unroll
        for (int d = 0; d < 2; ++d)
#pragma unroll
            for (int r = 0; r < 16; r += 2) accl[(d * 8 + (r >> 1)) * 64] = pk2(park[(d * 16 + r) * 64], park[(d * 16 + r + 1) * 64]); }
        nsa_reset(st);
        const bf16_t* ks = P + C_SK + g * 64; const bf16_t* vs = P + C_SV + g * 64;
        const unsigned m0 = selm[tokl * 4 + 0], m1 = selm[tokl * 4 + 1], m2 = selm[tokl * 4 + 2], m3 = selm[tokl * 4 + 3];
        int n = prev_bit128(ulo, uhi, 128);
        asm volatile("" : "+v"(ln));
        const NsaSrc Ss = nsa_src(ks, vs, PROJ_W, ln);
        if (n >= 0) nsa_issue_k(T, Ss, 64 * n);
        while (n >= 0) {
            int nx = prev_bit128(ulo, uhi, n);
            while (nx >= 0) {
                const unsigned mx_ = (nx < 32) ? m0 : (nx < 64) ? m1 : (nx < 96) ? m2 : m3; const bool rs = ((mx_ >> (nx & 31)) & 1u) != 0u;
                const float kn = __uint_as_float(__builtin_amdgcn_readlane(__float_as_uint(nx < 64 ? ksn_lo : ksn_hi), nx & 63));
                const float bound = qn * kn + 0.01f - slope2 * (float)(tq - (64 * nx + 63));
                if (!(__all(!rs || bound < st.m - NSA_THR) != 0)) break;
                nx = prev_bit128(ulo, uhi, nx);
            }
            const unsigned mw = (n < 32) ? m0 : (n < 64) ? m1 : (n < 96) ? m2 : m3;
            nsa_step<2>(st, T, qf, Ss, 64 * n, 64 * n, 1, tq, slope2, ((mw >> (n & 31)) & 1u) != 0u, vt, imp, 0, 0.f, ln, nx >= 0, 64 * nx);
            n = nx;
        }
        { const float lt = swap32_sum(st.l); const float sc = gates[1] / lt;
#pragma unroll
            for (int d = 0; d < 2; ++d)
#pragma unroll
                for (int r = 0; r < 16; r += 2) { const unsigned pv = accl[(d * 8 + (r >> 1)) * 64]; accl[(d * 8 + (r >> 1)) * 64] = pk2(bflo(pv) + st.o[d][r] * sc, bfhi(pv) + st.o[d][r + 1] * sc); } }
    }
    {
        nsa_reset(st);
        const bf16_t* kw = P + C_WK + g * 64; const bf16_t* vw = P + C_WV + g * 64;
        const int lo = tw0 - 511, nlo = lo > 0 ? (lo >> 6) : 0, nhi = (tw0 + 7) >> 6;
        asm volatile("" : "+v"(ln));
        const NsaSrc Sw = nsa_src(kw, vw, PROJ_W, ln);
        nsa_issue_k(T, Sw, 64 * nhi);
        for (int n = nhi; n >= nlo; --n) nsa_step<3>(st, T, qf, Sw, 64 * n, 64 * n, 1, tq, slope2, true, vt, imp, 0, 0.f, ln, n > nlo, 64 * (n - 1));
        const float lt = swap32_sum(st.l); const float sc = gates[2] / lt;
        bf16_t* orow = (bf16_t*)(C.ws + WS_OB) + (size_t)(b * SEQ + tq) * 512 + hq * 64;
#pragma unroll
        for (int d = 0; d < 2; ++d)
#pragma unroll
            for (int p = 0; p < 2; ++p) { unsigned pk_[2][2];
#pragma unroll
                for (int q = 0; q < 2; ++q) { const int g4 = 2 * p + q; const unsigned p0 = accl[(d * 8 + 2 * g4) * 64], p1 = accl[(d * 8 + 2 * g4 + 1) * 64];
                    pk_[q][0] = pk2(bflo(p0) + st.o[d][4 * g4] * sc, bfhi(p0) + st.o[d][4 * g4 + 1] * sc); pk_[q][1] = pk2(bflo(p1) + st.o[d][4 * g4 + 2] * sc, bfhi(p1) + st.o[d][4 * g4 + 3] * sc); }
                *(u32x4*)(orow + 32 * d + 8 * (2 * p + hi)) = pair_swap_store(pk_[0][0], pk_[0][1], pk_[1][0], pk_[1][1]); }
    }
}

constexpr int CONV_PER_UNIT = 24, N_CONV_UNITS = 3 * 64 * 128 / CONV_PER_UNIT;
__device__ __forceinline__ void conv_unit(const Ctx& C, int cu) {
    LAS float* scr = (LAS float*)(C.lds + C.wave * 16384);
    unsigned char* ws = C.ws;
#pragma unroll 1
    for (int j = 0; j < CONV_PER_UNIT / NWAVES; ++j) {
        int r = cu * CONV_PER_UNIT + j * NWAVES + C.wave;
        if (r < 64 * 128) { const int e = r >> 7; transpose_item(C.gin(23) + (size_t)e * 1024 * 256, 1024, 256, (bf16_t*)(ws + WS_WGU) + (size_t)e * 512 * 1024, 2, scr, r & 127, C.lane); continue; } r -= 64 * 128;
        if (r < 64 * 128) { const int e = r >> 7; transpose_item(C.gin(24) + (size_t)e * 1024 * 256, 1024, 256, (bf16_t*)(ws + WS_WGU) + (size_t)e * 512 * 1024, 3, scr, r & 127, C.lane); continue; } r -= 64 * 128;
        { const int e = r >> 7; transpose_item(C.gin(25) + (size_t)e * 256 * 1024, 256, 1024, (bf16_t*)(ws + WS_WDN) + (size_t)e * 1024 * 256, 0, scr, r & 127, C.lane); }
    }
}

__device__ __forceinline__ void attention_phase(const Ctx& C) {
    if (C.tid < 128) ((LAS float*)(C.lds + ATT_LDS_SW))[C.tid] = C.gin(10)[C.tid];
    float lam;
    { const float a = wave_sum(C.gin(6)[C.lane] * C.gin(7)[C.lane]), bq = wave_sum(C.gin(8)[C.lane] * C.gin(9)[C.lane]); lam = __expf(a) - __expf(bq) + 0.2f; }
    unsigned* gq = (unsigned*)(C.ws + WS_CTL) + 64;
    LAS int* qw = (LAS int*)(C.lds + ATT_LDS_Q);
    if (C.tid == 0) qw[0] = (int)__hip_atomic_fetch_add(gq, 1u, __ATOMIC_RELAXED, __HIP_MEMORY_SCOPE_AGENT);
    __syncthreads();
#pragma unroll 1
    for (int n = 0;; ++n) {
        const int uq = qw[n & 1]; if (uq >= 2048 + N_CONV_UNITS) break;
        int nq_ = 0; if (C.tid == 0) nq_ = (int)__hip_atomic_fetch_add(gq, 1u, __ATOMIC_RELAXED, __HIP_MEMORY_SCOPE_AGENT);
        if (uq < 3 * N_CONV_UNITS && (uq % 3) == 2) { conv_unit(C, uq / 3); }
        else { const int u = uq < 3 * N_CONV_UNITS ? uq - uq / 3 : uq - N_CONV_UNITS;
            da_unit(C, u & 3, 7 - ((u >> 2) & 7), 63 - (u >> 5), lam);
        }
        if (C.tid == 0) qw[(n + 1) & 1] = nq_;
        __syncthreads();
    }
    __syncthreads();
    if (C.tid == 0) qw[0] = (int)__hip_atomic_fetch_add(gq + 1, 1u, __ATOMIC_RELAXED, __HIP_MEMORY_SCOPE_AGENT);
    __syncthreads();
#pragma unroll 1
    for (int n = 0;; ++n) {
        const int u = qw[n & 1]; if (u >= 1024) break;
        int nq_ = 0; if (C.tid == 0) nq_ = (int)__hip_atomic_fetch_add(gq + 1, 1u, __ATOMIC_RELAXED, __HIP_MEMORY_SCOPE_AGENT);
        const int bg = ((u & 3) << 1) | (u < 512 ? 1 : 0), tile = 127 - ((u & 511) >> 2);
        nsa_unit(C, bg >> 1, bg & 1, tile * 64);
        if (C.tid == 0) qw[(n + 1) & 1] = nq_;
        __syncthreads();
    }
    __syncthreads();
}

__device__ __forceinline__ void router_bias(const Ctx& C) {
    const float* mod = (const float*)(C.ws + WS_MOD); LAS float* red = (LAS float*)C.lds;
    for (int i = C.bid; i < 256; i += C.G) { const int b = i >> 6, e = i & 63;
        const float* sh = mod + b * 6144 + 3072; const float* W = C.gin(21) + e;
        float a = sh[C.tid] * W[(size_t)C.tid * 64] + sh[C.tid + 512] * W[(size_t)(C.tid + 512) * 64];
        a = wave_sum(a);
        __syncthreads();
        if (C.lane == 0) red[C.wave] = a;
        __syncthreads();
        if (C.tid == 0) ((float*)(C.ws + WS_RBIAS))[i] = ((red[0] + red[1]) + (red[2] + red[3])) + ((red[4] + red[5]) + (red[6] + red[7]));
    }
}
constexpr int P7_LOG = 0;
constexpr int P7_ASG = 128 * 65 * 4;
constexpr int P7_LCNT = P7_ASG + 128 * 8 * 12;
constexpr int P7_PSTR = 68;
constexpr int P7_PART = P7_LCNT + 512;
constexpr int P7_RSTD = P7_PART + 8 * 32 * P7_PSTR * 4;
constexpr int P7_G = P7_RSTD + 512;
constexpr int P7_SH = P7_G + 4096;
constexpr int P7_BIAS = P7_SH + 4096;
static_assert(P7_BIAS + 256 <= 131072, "P7 LDS map");
__device__ __forceinline__ void route_phase(const Ctx& C) {
    const int lane = C.lane, wid = C.wave, fr = lane & 15, kq = lane >> 4;
    const float* mod = (const float*)(C.ws + WS_MOD);
    bf16_t* XN = (bf16_t*)(C.ws + WS_XN);
    static_assert(WS_RLO == WS_RHI + 131072, "hi and lo router weights are one 256 KiB buffer");
    const __amdgpu_buffer_rsrc_t rr = __builtin_amdgcn_make_buffer_rsrc((void*)(C.ws + WS_RHI), 0, 262144, 0x00020000);
    LAS float* logit = (LAS float*)(C.lds + P7_LOG) + wid * 16 * 65;
    LAS int* asg = (LAS int*)(C.lds + P7_ASG); LAS int* lcnt = (LAS int*)(C.lds + P7_LCNT); LAS int* lbase = lcnt + 64;
    LAS float* part = (LAS float*)(C.lds + P7_PART); LAS float* rstds = (LAS float*)(C.lds + P7_RSTD);
    LAS float* gv = (LAS float*)(C.lds + P7_G); LAS float* shv = (LAS float*)(C.lds + P7_SH); LAS float* biasp = (LAS float*)(C.lds + P7_BIAS);
    unsigned* gcnt = (unsigned*)(C.ws + WS_CTL);
    int* rowslot = (int*)(C.ws + WS_RSLOT); int* tokrow = (int*)(C.ws + WS_RW); float* tokw = (float*)(C.ws + WS_RW + 2 * MiB);
    for (int chunk = C.bid; chunk < NTOK / 128; chunk += C.G) {
        const int bb = (chunk * 128) / SEQ;
        if (C.tid < 64) lcnt[C.tid] = 0;
        for (int i = C.tid; i < 1024; i += NTHREADS) { gv[i] = C.gin(20)[i] * (mod[bb * 6144 + 4096 + i] + 1.0f); shv[i] = mod[bb * 6144 + 3072 + i]; }
        if (C.tid < 128) { const float* sp = (const float*)(C.ws + WS_LO) + chunk * 128 + C.tid; float a = 0.f;
#pragma unroll
            for (int p = 0; p < 16; ++p) a += sp[(size_t)p * NTOK];
            rstds[C.tid] = rsqrtf(a * (1.f / DM) + 1e-6f); }
        else if (C.tid < 192) biasp[C.tid - 128] = ((const float*)(C.ws + WS_RBIAS))[bb * 64 + C.tid - 128];
        __syncthreads();
        const int kb = 128 * wid + 8 * kq;
        const unsigned boff = (unsigned)(wid * 32768 + lane * 16);
        f32x4 v[2][4][2];
#pragma unroll
        for (int t = 0; t < 2; ++t) { const float* xr = C.out + (size_t)(chunk * 128 + 16 * t + fr) * DM + kb;
#pragma unroll
            for (int ks = 0; ks < 4; ++ks) { v[t][ks][0] = *(const f32x4*)(xr + 32 * ks); v[t][ks][1] = *(const f32x4*)(xr + 32 * ks + 4); } }
        bf16x8 b_h[4], b_l[4];
#pragma unroll
        for (int n = 0; n < 4; ++n) { b_h[n] = __builtin_bit_cast(bf16x8, __builtin_amdgcn_raw_buffer_load_b128(rr, boff, n * 2048, 0)); b_l[n] = __builtin_bit_cast(bf16x8, __builtin_amdgcn_raw_buffer_load_b128(rr, boff, n * 2048 + 1024, 0)); }
        __builtin_amdgcn_sched_barrier(0);
#pragma unroll 1
        for (int it = 0; it < 4; ++it) {
            const int r0 = chunk * 128 + it * 32, rn = it < 3 ? r0 + 32 : r0;
            f32x4 acc[2][4];
#pragma unroll
            for (int t = 0; t < 2; ++t)
#pragma unroll
                for (int n = 0; n < 4; ++n) acc[t][n] = (f32x4){0.f, 0.f, 0.f, 0.f};
            const float rs[2] = {rstds[it * 32 + fr], rstds[it * 32 + 16 + fr]};
#pragma unroll
            for (int ks = 0; ks < 4; ++ks) {
                const f32x4 g0 = *(const LAS f32x4*)(gv + kb + 32 * ks), g1 = *(const LAS f32x4*)(gv + kb + 32 * ks + 4);
                const f32x4 s0 = *(const LAS f32x4*)(shv + kb + 32 * ks), s1 = *(const LAS f32x4*)(shv + kb + 32 * ks + 4);
                bf16x8 a_h[2], a_l[2];
#pragma unroll
                for (int t = 0; t < 2; ++t) { const f32x4 u0 = v[t][ks][0] * g0, u1 = v[t][ks][1] * g1; u32x4 h, l;
                    { const float* xr = C.out + (size_t)(rn + 16 * t + fr) * DM + kb + 32 * ks; v[t][ks][0] = *(const f32x4*)xr; v[t][ks][1] = *(const f32x4*)(xr + 4); }
                    h.x = pk2(u0.x, u0.y); h.y = pk2(u0.z, u0.w); h.z = pk2(u1.x, u1.y); h.w = pk2(u1.z, u1.w);
                    l.x = pk2(u0.x - bflo(h.x), u0.y - bfhi(h.x)); l.y = pk2(u0.z - bflo(h.y), u0.w - bfhi(h.y)); l.z = pk2(u1.x - bflo(h.z), u1.y - bfhi(h.z)); l.w = pk2(u1.z - bflo(h.w), u1.w - bfhi(h.w));
                    a_h[t] = __builtin_bit_cast(bf16x8, h); a_l[t] = __builtin_bit_cast(bf16x8, l);
                    const f32x4 y0 = u0 * rs[t] + s0, y1 = u1 * rs[t] + s1;
                    u32x4 o; o.x = pk2(y0.x, y0.y); o.y = pk2(y0.z, y0.w); o.z = pk2(y1.x, y1.y); o.w = pk2(y1.z, y1.w);
                    *(u32x4*)(XN + (size_t)(r0 + 16 * t + fr) * DM + kb + 32 * ks) = o; }
#pragma unroll
                for (int n = 0; n < 4; ++n) {
#pragma unroll
                    for (int t = 0; t < 2; ++t) {
                        acc[t][n] = __builtin_amdgcn_mfma_f32_16x16x32_bf16(a_h[t], b_h[n], acc[t][n], 0, 0, 0);
                        acc[t][n] = __builtin_amdgcn_mfma_f32_16x16x32_bf16(a_l[t], b_h[n], acc[t][n], 0, 0, 0);
                        acc[t][n] = __builtin_amdgcn_mfma_f32_16x16x32_bf16(a_h[t], b_l[n], acc[t][n], 0, 0, 0); }
                    b_h[n] = __builtin_bit_cast(bf16x8, __builtin_amdgcn_raw_buffer_load_b128(rr, boff, ((ks + 1) & 3) * 8192 + n * 2048, 0)); b_l[n] = __builtin_bit_cast(bf16x8, __builtin_amdgcn_raw_buffer_load_b128(rr, boff, ((ks + 1) & 3) * 8192 + n * 2048 + 1024, 0)); }
                __builtin_amdgcn_sched_barrier(0);
            }
#pragma unroll
            for (int t = 0; t < 2; ++t)
#pragma unroll
                for (int n = 0; n < 4; ++n)
#pragma unroll
                    for (int i = 0; i < 4; ++i) part[(wid * 32 + 16 * t + 4 * kq + i) * P7_PSTR + 16 * n + fr] = acc[t][n][i];
            asm volatile("s_waitcnt lgkmcnt(0)" ::: "memory"); __builtin_amdgcn_s_barrier(); asm volatile("" ::: "memory");
            {
                const int row = C.tid >> 4, e4 = (C.tid & 15) * 4; f32x4 sum = (f32x4){0.f, 0.f, 0.f, 0.f};
#pragma unroll
                for (int w = 0; w < 8; ++w) sum += *(const LAS f32x4*)(part + (w * 32 + row) * P7_PSTR + e4);
                const float rstd = rstds[it * 32 + row];
                LAS float* lo = (LAS float*)(C.lds + P7_LOG) + (it * 32 + row) * 65 + e4;
#pragma unroll
                for (int j = 0; j < 4; ++j) lo[j] = rstd * sum[j] + biasp[e4 + j];
            }
            asm volatile("s_waitcnt lgkmcnt(0)" ::: "memory"); __builtin_amdgcn_s_barrier(); asm volatile("" ::: "memory");
        }
        {
            const int rrow = lane >> 2, q = lane & 3; LAS const float* L = logit + rrow * 65 + 16 * q; const float* rb = C.gin(22) + 16 * q;
            float sc[16], bs[16];
#pragma unroll
            for (int i = 0; i < 16; ++i) { sc[i] = sigmoidf_(L[i]); bs[i] = sc[i] + rb[i]; }
            float gsc[2];
#pragma unroll
            for (int gi = 0; gi < 2; ++gi) { float t1 = NEG_INF, t2 = NEG_INF;
#pragma unroll
                for (int i = 0; i < 8; ++i) { const float v = bs[8 * gi + i]; if (v > t1) { t2 = t1; t1 = v; } else if (v > t2) t2 = v; }
                gsc[gi] = t1 + t2; }
            bool gsel[2] = {false, false};
#pragma unroll
            for (int it = 0; it < 4; ++it) {
                float bv = NEG_INF; int bi = 1 << 20;
                if (!gsel[0]) { bv = gsc[0]; bi = 2 * q; }
                if (!gsel[1] && gsc[1] > bv) { bv = gsc[1]; bi = 2 * q + 1; }
#pragma unroll
                for (int st_ = 0; st_ < 2; ++st_) { const float ov = st_ ? dpp_f<DPP_XOR2>(bv) : dpp_f<DPP_XOR1>(bv); const int oi = st_ ? dpp_i<DPP_XOR2>(bi) : dpp_i<DPP_XOR1>(bi); if (ov > bv || (ov == bv && oi < bi)) { bv = ov; bi = oi; } }
                if (bi == 2 * q) gsel[0] = true; if (bi == 2 * q + 1) gsel[1] = true;
            }
#pragma unroll
            for (int i = 0; i < 16; ++i) if (!gsel[i >> 3]) bs[i] = NEG_INF;
            int te[8]; float tw[8]; float wsum = 0.f;
#pragma unroll
            for (int k = 0; k < 8; ++k) {
                float bv = bs[0]; int bi = 0;
#pragma unroll
                for (int i = 1; i < 16; ++i) if (bs[i] > bv) { bv = bs[i]; bi = i; }
                float bw = sc[0];
#pragma unroll
                for (int i = 1; i < 16; ++i) bw = (bi == i) ? sc[i] : bw;
                int be = 16 * q + bi;
#pragma unroll
                for (int st_ = 0; st_ < 2; ++st_) { const float ov = st_ ? dpp_f<DPP_XOR2>(bv) : dpp_f<DPP_XOR1>(bv); const int oe = st_ ? dpp_i<DPP_XOR2>(be) : dpp_i<DPP_XOR1>(be); const float ow = st_ ? dpp_f<DPP_XOR2>(bw) : dpp_f<DPP_XOR1>(bw); if (ov > bv || (ov == bv && oe < be)) { bv = ov; be = oe; bw = ow; } }
#pragma unroll
                for (int i = 0; i < 16; ++i) if (16 * q + i == be) bs[i] = NEG_INF;
                te[k] = be; tw[k] = bw; wsum += bw;
            }
            const float wn = 2.5f / wsum; const int lrow = wid * 16 + rrow;
#pragma unroll
            for (int k = 0; k < 8; ++k) if ((k >> 1) == q) { const int posl = atomicAdd((int*)(lcnt + te[k]), 1); LAS int* a = asg + (lrow * 8 + k) * 3; a[0] = te[k]; a[1] = posl; a[2] = __float_as_int(tw[k] * wn); }
        }
        __syncthreads();
        if (C.tid < 64) lbase[C.tid] = (int)atomicAdd(gcnt + C.tid, (unsigned)lcnt[C.tid]);
        __syncthreads();
        for (int i = C.tid; i < 1024; i += NTHREADS) { LAS int* a = asg + i * 3; const int e = a[0]; const size_t li = (size_t)e * CAP + lbase[e] + a[1];
            const int slot = (chunk * 128 + (i >> 3)) * 8 + (i & 7);
            rowslot[li] = slot; tokrow[slot] = e | ((lbase[e] + a[1]) << 8); tokw[slot] = __int_as_float(a[2]); }
        __syncthreads();
    }
}

constexpr int MISC_OFF = 131072 + 1024;
constexpr int SCHED_OFF = 131072;
constexpr int TEXP_OFF = 131072 + 2048;
__device__ __forceinline__ int build_sched(const Ctx& C) {
    LAS int* tstart = (LAS int*)(C.lds + SCHED_OFF); LAS int* astart = tstart + 66; LAS unsigned char* texp = C.lds + TEXP_OFF;
    __syncthreads();
    if (C.wave == 0) { const unsigned* gcnt = (const unsigned*)(C.ws + WS_CTL);
        const int c = (int)__hip_atomic_load(gcnt + C.lane, __ATOMIC_RELAXED, __HIP_MEMORY_SCOPE_AGENT); const int tl = (c + 255) >> 8;
        int as = c, ts = tl;
#pragma unroll
        for (int o = 1; o < 64; o <<= 1) { const int ua = __shfl_up(as, o), ut = __shfl_up(ts, o); if (C.lane >= o) { as += ua; ts += ut; } }
        astart[C.lane] = as - c; tstart[C.lane] = ts - tl;
        if (C.lane == 63) { tstart[64] = ts; astart[64] = NTOK * 8; tstart[65] = ts + NTOK / 256; astart[65] = NTOK * 8 + NTOK; } }
    __syncthreads();
    if (C.tid < 65) for (int mt = tstart[C.tid]; mt < tstart[C.tid + 1]; ++mt) texp[mt] = (unsigned char)C.tid;
    __syncthreads();
    return tstart[65];
}

__device__ __forceinline__ f32x4 bf4lo(const u32x4& y) { return (f32x4){bflo(y.x), bfhi(y.x), bflo(y.y), bfhi(y.y)}; }
__device__ __forceinline__ f32x4 bf4hi(const u32x4& y) { return (f32x4){bflo(y.z), bfhi(y.z), bflo(y.w), bfhi(y.w)}; }
template <bool FINAL>
__device__ __forceinline__ void combine_round(const Ctx& C, int j) {
    const int gw = C.bid * NWAVES + C.wave, NGW = C.G * NWAVES; const float* mod = (const float*)(C.ws + WS_MOD);
    const bf16_t* YS = (const bf16_t*)(C.ws + WS_YS); const int* tokrow = (const int*)(C.ws + WS_RW); const float* tokw = (const float*)(C.ws + WS_RW + 2 * MiB);
    const LAS int* astart = (const LAS int*)(C.lds + SCHED_OFF) + 66;
    static_assert(NSPLIT == 2 && YW == 512, "two column rounds of 512, 8 columns per lane");
    if (FINAL) asm volatile("s_waitcnt vmcnt(0)" ::: "memory");
    const int c = 8 * C.lane;
    f32x4 fw4[4] = {};
    if (FINAL) { const float* fw = C.gin(29); fw4[0] = *(const f32x4*)(fw + c); fw4[1] = *(const f32x4*)(fw + c + 4); fw4[2] = *(const f32x4*)(fw + YW + c); fw4[3] = *(const f32x4*)(fw + YW + c + 4); }
    unsigned* qcnt = (unsigned*)(C.ws + WS_CTL) + CW_CMBQ + j; LAS int* qw = (LAS int*)C.lds;
    if (C.tid == 0) qw[0] = (int)__hip_atomic_fetch_add(qcnt, 1u, __ATOMIC_RELAXED, __HIP_MEMORY_SCOPE_AGENT);
    __syncthreads();
#pragma unroll 1
    for (int n = 0;; ++n) {
    const int ch = qw[n & 1]; if (ch >= NTOK / 64) break;
    int nq_ = 0; if (C.tid == 0) nq_ = (int)__hip_atomic_fetch_add(qcnt, 1u, __ATOMIC_RELAXED, __HIP_MEMORY_SCOPE_AGENT);
    const int mb = ch * 64 + C.wave * 8;
    u32x4 ra[2], rb[2]; f32x4 wa[2], wb[2];
#pragma unroll
    for (int q = 0; q < 2; ++q) { ra[q] = *(const u32x4*)(tokrow + (size_t)(mb + q) * 8); rb[q] = *(const u32x4*)(tokrow + (size_t)(mb + q) * 8 + 4); wa[q] = *(const f32x4*)(tokw + (size_t)(mb + q) * 8); wb[q] = *(const f32x4*)(tokw + (size_t)(mb + q) * 8 + 4); }
#pragma unroll 1
    for (int m0 = mb; m0 < mb + 8; m0 += 2) {
        const int b = m0 / SEQ;
        u32x4 y[2][9]; float ww[2][8]; f32x4 xa[2], xb[2], pa[2], pb[2];
#pragma unroll
        for (int q = 0; q < 2; ++q) { const int m = m0 + q;
            const unsigned rr[8] = {ra[q].x, ra[q].y, ra[q].z, ra[q].w, rb[q].x, rb[q].y, rb[q].z, rb[q].w};
#pragma unroll
            for (int k = 0; k < 4; ++k) { ww[q][k] = wa[q][k]; ww[q][4 + k] = wb[q][k]; }
#pragma unroll
            for (int k = 0; k < 8; ++k) { const int row = astart[rr[k] & 255u] + (int)(rr[k] >> 8); y[q][k] = __builtin_nontemporal_load((const u32x4*)(YS + (size_t)row * YW + c)); }
            y[q][8] = __builtin_nontemporal_load((const u32x4*)(YS + ((size_t)NTOK * 8 + m) * YW + c));
            const float* xr = C.out + (size_t)m * DM;
            xa[q] = __builtin_nontemporal_load((const f32x4*)(xr + j * YW + c)); xb[q] = __builtin_nontemporal_load((const f32x4*)(xr + j * YW + c + 4));
            if (FINAL) { pa[q] = *(const f32x4*)(xr + c); pb[q] = *(const f32x4*)(xr + c + 4); } }
        if (m0 + 2 < mb + 8) {
#pragma unroll
            for (int q = 0; q < 2; ++q) { const int mn = m0 + 2 + q; ra[q] = *(const u32x4*)(tokrow + (size_t)mn * 8); rb[q] = *(const u32x4*)(tokrow + (size_t)mn * 8 + 4); wa[q] = *(const f32x4*)(tokw + (size_t)mn * 8); wb[q] = *(const f32x4*)(tokw + (size_t)mn * 8 + 4); } }
        const float* g2 = mod + b * 6144 + 5120 + j * YW + c; const f32x4 g2a = *(const f32x4*)g2, g2b = *(const f32x4*)(g2 + 4);
#pragma unroll
        for (int q = 0; q < 2; ++q) { const int m = m0 + q; float* xr = C.out + (size_t)m * DM;
            f32x4 a0 = bf4lo(y[q][8]), a1 = bf4hi(y[q][8]);
#pragma unroll
            for (int k = 0; k < 8; ++k) { a0 += bf4lo(y[q][k]) * ww[q][k]; a1 += bf4hi(y[q][k]) * ww[q][k]; }
            const f32x4 q0 = xa[q] + g2a * a0, q1 = xb[q] + g2b * a1;
            if (!FINAL) { *(f32x4*)(xr + j * YW + c) = q0; *(f32x4*)(xr + j * YW + c + 4) = q1; }
            else {
                const f32x4 p0 = pa[q], p1 = pb[q];
                float ss = (p0.x * p0.x + p0.y * p0.y) + (p0.z * p0.z + p0.w * p0.w) + (p1.x * p1.x + p1.y * p1.y) + (p1.z * p1.z + p1.w * p1.w)
                         + (q0.x * q0.x + q0.y * q0.y) + (q0.z * q0.z + q0.w * q0.w) + (q1.x * q1.x + q1.y * q1.y) + (q1.z * q1.z + q1.w * q1.w);
                const float rstd = rsqrtf(wave_sum(ss) * (1.f / DM) + 1e-6f);
                *(f32x4*)(xr + c) = p0 * rstd * fw4[0]; *(f32x4*)(xr + c + 4) = p1 * rstd * fw4[1];
                *(f32x4*)(xr + YW + c) = q0 * rstd * fw4[2]; *(f32x4*)(xr + YW + c + 4) = q1 * rstd * fw4[3];
            }
        }
    }
    if (C.tid == 0) qw[(n + 1) & 1] = nq_;
    __syncthreads();
    }
}

__global__ void __launch_bounds__(NTHREADS, 2) mega_fwd(const float* i0, const float* i1, const float* i2, const float* i3, const float* i4, const float* i5, const float* i6, const float* i7, const float* i8, const float* i9, const float* i10, const float* i11, const float* i12, const float* i13, const float* i14, const float* i15, const float* i16, const float* i17, const float* i18, const float* i19, const float* i20, const float* i21, const float* i22, const float* i23, const float* i24, const float* i25, const float* i26, const float* i27, const float* i28, const float* i29, float* out_arg, unsigned char* ws_arg) {
    extern __shared__ __attribute__((aligned(16))) unsigned char lds_raw[];
    Ctx C; C.lds = (LAS unsigned char*)lds_raw; C.tid = threadIdx.x; C.lane = C.tid & 63; C.wave = __builtin_amdgcn_readfirstlane(C.tid >> 6); C.G = gridDim.x; C.bid = blockIdx.x;
    C.in[0] = i0; C.in[1] = i1; C.in[2] = i2; C.in[3] = i3; C.in[4] = i4; C.in[5] = i5; C.in[6] = i6; C.in[7] = i7; C.in[8] = i8; C.in[9] = i9; C.in[10] = i10; C.in[11] = i11; C.in[12] = i12; C.in[13] = i13; C.in[14] = i14; C.in[15] = i15; C.in[16] = i16; C.in[17] = i17; C.in[18] = i18; C.in[19] = i19; C.in[20] = i20; C.in[21] = i21; C.in[22] = i22; C.in[23] = i23; C.in[24] = i24; C.in[25] = i25; C.in[26] = i26; C.in[27] = i27; C.in[28] = i28; C.in[29] = i29;
    C.out = out_arg; C.ws = ws_arg;
    unsigned char* ws = C.ws;
    LAS unsigned char* lds = C.lds;
    if (C.tid < 4) ((LAS unsigned*)(lds + MISC_OFF))[C.tid] = 0u;
    __syncthreads();
    const XcdBarrier xbar = xcd_barrier_post((unsigned*)(ws + WS_BAR), (volatile LAS unsigned*)(lds + MISC_OFF));
#define GSYNC() xcd_barrier(xbar)

#define LAUNDER() do { size_t z_ = 0; asm volatile("" : "+s"(z_)); C.ws = ws_arg + z_; C.out = out_arg + z_; ws = C.ws; int t_ = threadIdx.x; asm volatile("" : "+v"(t_)); C.tid = t_; C.lane = t_ & 63; C.wave = __builtin_amdgcn_readfirstlane(t_ >> 6); } while (0)
    LAUNDER(); p0_prologue(C);
    GSYNC();
    LAUNDER(); modulate_rows(C, C.gin(0), C.gin(4), 0, 1024, (bf16_t*)(ws + WS_XN));
    router_bias(C);
    GSYNC();
    {
        LAUNDER();
        pg8::Gemm g{(const bf16_t*)(ws + WS_XN), (const bf16_t*)(ws + WS_WIN), DM}; pg8::DenseSched S; S.init(NTOK, NIN, C.G, C.bid);
        EpiProj E{(bf16_t*)(ws + WS_PROJ), (bf16_t*)C.out, (float*)(ws + WS_NSAG)};
        pg8::gemm_phase<EpiProj, pg8::DenseSched, false>(lds, g, S, E);
    }
    GSYNC();
    LAUNDER(); compress_phase(C); knorm_phase(C);
    GSYNC();
    LAUNDER(); attention_phase(C);
    GSYNC();
    {
        LAUNDER();
        pg8::DenseSched S; S.init(NTOK, DM, C.G, C.bid);
        pg8::Gemm ga{(const bf16_t*)(ws + WS_XN), (const bf16_t*)(ws + WS_WDA), 1024};
        EpiGate<false> Ea{(bf16_t*)(ws + WS_MERGED), (const bf16_t*)C.out, 0};
        pg8::gemm_phase<EpiGate<false>, pg8::DenseSched, false>(lds, ga, S, Ea);
        LAUNDER();
        pg8::Gemm gb{(const bf16_t*)(ws + WS_OB), (const bf16_t*)(ws + WS_WNSA), 512};
        EpiGate<true> Eb{(bf16_t*)(ws + WS_MERGED), (const bf16_t*)C.out, 1024};
        pg8::gemm_phase<EpiGate<true>, pg8::DenseSched, false>(lds, gb, S, Eb);
    }
    GSYNC();
    {
        LAUNDER();
        pg8::DenseSched S; S.init(NTOK, DM, C.G, C.bid);
        pg8::Gemm g{(const bf16_t*)(ws + WS_MERGED), (const bf16_t*)(ws + WS_WO), 1024};
        EpiResid E{C.gin(0), (const float*)(ws + WS_MOD), C.out, (float*)(ws + WS_LO)};
        pg8::gemm_phase<EpiResid, pg8::DenseSched, false>(lds, g, S, E);
    }
    GSYNC();
    LAUNDER(); route_phase(C);
    GSYNC();
    LAUNDER();
    const int ntile = build_sched(C);
    const LAS int* tstart = (const LAS int*)(lds + SCHED_OFF); const LAS int* astart = tstart + 66; const LAS unsigned char* texp = lds + TEXP_OFF;
    {
        LAUNDER();
        pg8::Gemm g{(const bf16_t*)(ws + WS_XN), (const bf16_t*)(ws + WS_WGU), 1024};
        pg8::ExpertSched S{tstart, astart, texp, (const int*)(ws + WS_RSLOT), ntile, 2, 2, 0, C.G, C.bid};
        EpiAct E{(bf16_t*)(ws + WS_ACT), astart};
        pg8::gemm_phase<EpiAct, pg8::ExpertSched, true>(lds, g, S, E);
    }
    GSYNC();
#pragma unroll 1
    for (int j = 0; j < NSPLIT; ++j) {
        {
            LAUNDER();
            pg8::Gemm g{(const bf16_t*)(ws + WS_ACT), (const bf16_t*)(ws + WS_WDN), 256};
            pg8::ExpertSched S{tstart, astart, texp, (const int*)(ws + WS_RSLOT), ntile, YW / 256, 4, j * (YW / 256), C.G, C.bid};
            EpiDown E{(bf16_t*)(ws + WS_YS), astart};
            pg8::gemm_phase<EpiDown, pg8::ExpertSched, false, false>(lds, g, S, E);
        }
        GSYNC();
        LAUNDER();
        if (j + 1 < NSPLIT) { combine_round<false>(C, j); GSYNC(); } else combine_round<true>(C, j);
    }
}

extern "C" void kernel_launch(void* const* d_in, const int* in_sizes, int n_in,
                              void* d_out, int out_size, void* d_ws, size_t ws_size,
                              hipStream_t stream) {
    static int grid_blocks = 0;
    if (!grid_blocks) {
        int dev = 0, cus = 0, per_cu = 0;
        (void)hipGetDevice(&dev);
        (void)hipDeviceGetAttribute(&cus, hipDeviceAttributeMultiprocessorCount, dev);
        (void)hipFuncSetAttribute((const void*)mega_fwd, hipFuncAttributeMaxDynamicSharedMemorySize, LDS_BYTES);
        (void)hipOccupancyMaxActiveBlocksPerMultiprocessor(&per_cu, (const void*)mega_fwd, NTHREADS, LDS_BYTES);
        grid_blocks = cus;
        if (per_cu < 1 || ws_size < WS_END || n_in != 30) { fprintf(stderr, "kernel_launch: per_cu=%d ws=%zu n_in=%d: cannot run\n", per_cu, ws_size, n_in); grid_blocks = -1; }
    }
    if (grid_blocks < 0) return;
    (void)hipMemsetAsync(d_ws, 0, 32768, stream);
    static const void* ptrs[32];
    for (int i = 0; i < 30; ++i) ptrs[i] = d_in[i];
    ptrs[30] = d_out; ptrs[31] = d_ws;
    void* args[32];
    for (int i = 0; i < 32; ++i) args[i] = (void*)&ptrs[i];
    hipError_t e = hipLaunchCooperativeKernel((const void*)mega_fwd, dim3(grid_blocks), dim3(NTHREADS), args, LDS_BYTES, stream);
    if (e != hipSuccess) fprintf(stderr, "cooperative launch failed: %s (grid %d)\n", hipGetErrorString(e), grid_blocks);
}
```
